# Optimizing an MI355X kernel written in HIP

```python
import math
import jax, jax.numpy as jnp
from jax import lax
import numpy as np

D_MODEL = 1024
BATCH = 8
SEQ = 2048
DEPTH = 1
DEC_BATCH = 32
DEC_SEQ = 8
PAST_LEN = 8192
PAGE_SIZE = 128

D_MIX = D_MODEL
D_CONV = D_MIX // 2
CONV_GROUPS = 8
CONV_WIDTH = 3
N_HEADS = 4
D_HEAD = 64
D_V = 2 * D_HEAD
D_ATTN = N_HEADS * D_V
D_QK = N_HEADS * 2 * D_HEAD
D_IN = 3 * D_CONV + 2 * D_QK + D_ATTN
D_FF = 4 * D_MODEL
Q_BLOCK = 128
EPS = 1e-5
NEG = -1e30

kernel_name = 'hymba_conv_diffattn_alibi_step'


def rmsnorm(x, g):
    xf = x.astype(jnp.float32)
    y = xf * lax.rsqrt(jnp.mean(xf * xf, axis=-1, keepdims=True) + EPS)
    return (y * g.astype(jnp.float32)).astype(x.dtype)


def alibi_slopes():
    return jnp.asarray([2.0 ** (-8.0 * (h + 1) / N_HEADS) for h in range(N_HEADS)], jnp.float32)


def project(h, w_in):
    z = h @ w_in
    cuts = [D_CONV, 2 * D_CONV, 3 * D_CONV, 3 * D_CONV + D_QK, 3 * D_CONV + 2 * D_QK]
    b, c, u, q, k, v = jnp.split(z, cuts, axis=-1)
    bsz, t = h.shape[:2]
    q = q.reshape(bsz, t, N_HEADS, 2, D_HEAD)
    k = k.reshape(bsz, t, N_HEADS, 2, D_HEAD)
    v = v.reshape(bsz, t, N_HEADS, D_V)
    return b, c, u, q, k, v


def short_conv(b, c, u, state, w):
    cu = c * u
    ext = jnp.concatenate([state.astype(cu.dtype), cu], axis=1)
    t = cu.shape[1]
    y = sum(ext[:, j:j + t] * w[j] for j in range(CONV_WIDTH))
    return b * y, ext[:, ext.shape[1] - (CONV_WIDTH - 1):]


def diff_attn(q, k, v, q_pos, k_pos, lam):
    s = jnp.einsum('bqhcd,bkhcd->bchqk', q, k, preferred_element_type=jnp.float32) * (D_HEAD ** -0.5)
    dist = q_pos[:, None] - k_pos[None, :]
    bias = -alibi_slopes()[:, None, None] * dist.astype(jnp.float32)[None]
    s = jnp.where((dist >= 0)[None, None, None], s + bias[None, None], NEG)
    p = jax.nn.softmax(s, axis=-1)
    a = p[:, 0] - lam * p[:, 1]
    return jnp.einsum('bhqk,bkhd->bqhd', a.astype(v.dtype), v)


def prompt_attention(q, k, v, lam):
    bsz, t = q.shape[:2]
    n_blocks = t // Q_BLOCK
    k_pos = jnp.arange(t)

    def block(i):
        qs = lax.dynamic_slice_in_dim(q, i * Q_BLOCK, Q_BLOCK, axis=1)
        return diff_attn(qs, k, v, i * Q_BLOCK + jnp.arange(Q_BLOCK), k_pos, lam)

    o = lax.map(block, jnp.arange(n_blocks))
    return jnp.moveaxis(o, 0, 1).reshape(bsz, t, N_HEADS, D_V)


def sample_attention(q, k, v, lam, k_pool, v_pool, page_table):
    bd, tn = q.shape[:2]
    past = page_table.shape[1] * PAGE_SIZE
    kp = k_pool[page_table].reshape(bd, past, N_HEADS, 2, D_HEAD)
    vp = v_pool[page_table].reshape(bd, past, N_HEADS, D_V)
    k_all = jnp.concatenate([kp.astype(k.dtype), k], axis=1)
    v_all = jnp.concatenate([vp.astype(v.dtype), v], axis=1)
    return diff_attn(q, k_all, v_all, past + jnp.arange(tn), jnp.arange(past + tn), lam)


def block_forward(x, conv_state, attend, norm1_g, w_in, conv_w, lam, lam_init, subln_g,
                  w_out, norm2_g, w_up, w_down):
    h = rmsnorm(x, norm1_g)
    b, c, u, q, k, v = project(h, w_in)
    y_conv, new_conv = short_conv(b, c, u, conv_state, conv_w)
    o = attend(q, k, v, lam)
    o = rmsnorm(o, subln_g) * (1.0 - lam_init)
    o = o.reshape(o.shape[0], o.shape[1], D_ATTN)
    x = x + jnp.concatenate([y_conv, o.astype(y_conv.dtype)], axis=-1) @ w_out
    h2 = rmsnorm(x, norm2_g)
    x = x + jnp.square(jax.nn.relu(h2 @ w_up)) @ w_down
    return x, k, v, new_conv


def setup_inputs(seed: int = 0) -> dict:
    key = jax.random.key(seed)
    ks = jax.random.split(key, 24)
    n_pages = PAST_LEN // PAGE_SIZE
    n_used = DEC_BATCH * n_pages
    n_pool = (n_used * 5) // 4
    f32 = jnp.float32
    nrm = lambda k, s, sc: jax.random.normal(k, s, f32) * sc
    page_table = jax.random.permutation(ks[5], n_pool)[:n_used].reshape(DEC_BATCH, n_pages).astype(jnp.int32)
    return {
        'x_prompt': nrm(ks[0], (BATCH, SEQ, D_MODEL), 1.0),
        'x_sample': nrm(ks[1], (DEC_BATCH, DEC_SEQ, D_MODEL), 1.0),
        'cache_k': nrm(ks[2], (DEPTH, n_pool, PAGE_SIZE, N_HEADS, 2, D_HEAD), 1.0),
        'cache_v': nrm(ks[3], (DEPTH, n_pool, PAGE_SIZE, N_HEADS, D_V), 1.0),
        'state_conv': nrm(ks[4], (DEPTH, DEC_BATCH, CONV_WIDTH - 1, D_CONV), 1.0),
        'page_table': page_table,
        'norm1_g': 1.0 + nrm(ks[6], (DEPTH, D_MODEL), 0.02),
        'w_in': nrm(ks[7], (DEPTH, D_MODEL, D_IN), D_MODEL ** -0.5),
        'conv_w': nrm(ks[8], (DEPTH, CONV_WIDTH, D_CONV), CONV_WIDTH ** -0.5),
        'lambda_q1': nrm(ks[9], (DEPTH, D_HEAD), 0.1),
        'lambda_k1': nrm(ks[10], (DEPTH, D_HEAD), 0.1),
        'lambda_q2': nrm(ks[11], (DEPTH, D_HEAD), 0.1),
        'lambda_k2': nrm(ks[12], (DEPTH, D_HEAD), 0.1),
        'subln_g': 1.0 + nrm(ks[13], (DEPTH, D_V), 0.02),
        'w_out': nrm(ks[14], (DEPTH, D_MIX, D_MODEL), D_MIX ** -0.5),
        'norm2_g': 1.0 + nrm(ks[15], (DEPTH, D_MODEL), 0.02),
        'w_up': nrm(ks[16], (DEPTH, D_MODEL, D_FF), D_MODEL ** -0.5),
        'w_down': nrm(ks[17], (DEPTH, D_FF, D_MODEL), D_FF ** -0.5),
        'final_g': 1.0 + nrm(ks[18], (D_MODEL,), 0.02),
    }


def reference(x_prompt, x_sample, cache_k, cache_v, state_conv, page_table,
              norm1_g, w_in, conv_w, lambda_q1, lambda_k1, lambda_q2, lambda_k2,
              subln_g, w_out, norm2_g, w_up, w_down, final_g):
    xp, xs = x_prompt, x_sample
    kp_l, vp_l, cp_l, ks_l, vs_l, cs_l = [], [], [], [], [], []
    for l in range(DEPTH):
        lam_init = 0.8 - 0.6 * math.exp(-0.3 * l)
        lam = (jnp.exp(jnp.sum(lambda_q1[l].astype(jnp.float32) * lambda_k1[l].astype(jnp.float32)))
               - jnp.exp(jnp.sum(lambda_q2[l].astype(jnp.float32) * lambda_k2[l].astype(jnp.float32)))
               + lam_init)
        params = (norm1_g[l], w_in[l], conv_w[l], lam, lam_init, subln_g[l],
                  w_out[l], norm2_g[l], w_up[l], w_down[l])
        zero_state = jnp.zeros((xp.shape[0], CONV_WIDTH - 1, D_CONV), xp.dtype)
        xp, kp, vp, cp = block_forward(xp, zero_state, prompt_attention, *params)
        k_pool, v_pool = cache_k[l], cache_v[l]
        attend_s = lambda q, k, v, lm: sample_attention(q, k, v, lm, k_pool, v_pool, page_table)
        xs, ks_, vs_, cs_ = block_forward(xs, state_conv[l], attend_s, *params)
        kp_l.append(kp); vp_l.append(vp); cp_l.append(cp)
        ks_l.append(ks_); vs_l.append(vs_); cs_l.append(cs_)
    y_prompt = rmsnorm(xp, final_g)
    y_sample = rmsnorm(xs, final_g)
    return (y_prompt, y_sample, jnp.stack(kp_l), jnp.stack(vp_l), jnp.stack(cp_l),
            jnp.stack(ks_l), jnp.stack(vs_l), jnp.stack(cs_l))
```

```cpp
#include <hip/hip_runtime.h>
#include <cstdint>
#include <cstdio>

namespace {
constexpr int D = 1024, BATCH = 8, SEQ = 2048, DEC_B = 32, DEC_S = 8, PAST = 8192, PAGE = 128, NPAGES = PAST / PAGE;
constexpr int MP = BATCH * SEQ, MS = DEC_B * DEC_S, M = MP + MS;
constexpr int DIN = 3072, FF = 4096;
constexpr int C_B = 0, C_C = 512, C_U = 1024, C_Q = 1536, C_K = 2048, C_V = 2560;
constexpr float EPS = 1e-5f;
constexpr size_t O_Y = 0, O_KP = (size_t)M * D, O_VP = O_KP + (size_t)MP * 512, O_CP = O_VP + (size_t)MP * 512,
                 O_KS = O_CP + 8 * 2 * 512, O_VS = O_KS + (size_t)MS * 512, O_CS = O_VS + (size_t)MS * 512, O_END = O_CS + 32 * 2 * 512;
static_assert(O_END == 34119680, "out size");

__device__ __forceinline__ float wave_sum(float v) {
#pragma unroll
    for (int o = 1; o < 64; o <<= 1) v += __shfl_xor(v, o);
    return v;
}
__device__ __forceinline__ float wave_max(float v) {
#pragma unroll
    for (int o = 1; o < 64; o <<= 1) v = fmaxf(v, __shfl_xor(v, o));
    return v;
}

__global__ void __launch_bounds__(256) k_rmsnorm(const float* xa, const float* xb, int rows_a, const float* g, float* out, int nrows) {
    const int w = blockIdx.x * 4 + (threadIdx.x >> 6), lane = threadIdx.x & 63;
    if (w >= nrows) return;
    const float* xr = (w < rows_a) ? xa + (size_t)w * D : xb + (size_t)(w - rows_a) * D;
    float4 v[4]; float s = 0.f;
#pragma unroll
    for (int j = 0; j < 4; ++j) { v[j] = ((const float4*)xr)[lane + 64 * j]; s += v[j].x * v[j].x + v[j].y * v[j].y + v[j].z * v[j].z + v[j].w * v[j].w; }
    const float r = rsqrtf(wave_sum(s) * (1.f / D) + EPS);
#pragma unroll
    for (int j = 0; j < 4; ++j) { const float4 gg = ((const float4*)g)[lane + 64 * j];
        float4 o; o.x = v[j].x * r * gg.x; o.y = v[j].y * r * gg.y; o.z = v[j].z * r * gg.z; o.w = v[j].w * r * gg.w;
        ((float4*)(out + (size_t)w * D))[lane + 64 * j] = o; }
}

template <int MODE>
__global__ void __launch_bounds__(256) k_gemm(const float* A, const float* B, float* C, int Mr, int N, int K, const float* Ra, const float* Rb, int rows_a) {
    __shared__ float As[16][64 + 4];
    __shared__ float Bs[16][64 + 4];
    const int t = threadIdx.x, tx = t & 15, ty = t >> 4;
    const int m0 = blockIdx.y * 64, n0 = blockIdx.x * 64;
    float acc[4][4] = {};
    for (int k0 = 0; k0 < K; k0 += 16) {
        { const int r = t >> 2, kk = (t & 3) * 4; const float4 a = *(const float4*)(A + (size_t)(m0 + r) * K + k0 + kk);
          As[kk + 0][r] = a.x; As[kk + 1][r] = a.y; As[kk + 2][r] = a.z; As[kk + 3][r] = a.w; }
        { const int kk = t >> 4, n = (t & 15) * 4; const float4 b = *(const float4*)(B + (size_t)(k0 + kk) * N + n0 + n);
          *(float4*)&Bs[kk][n] = b; }
        __syncthreads();
#pragma unroll
        for (int kk = 0; kk < 16; ++kk) {
            const float4 a = *(const float4*)&As[kk][ty * 4]; const float4 b = *(const float4*)&Bs[kk][tx * 4];
            const float av[4] = {a.x, a.y, a.z, a.w}, bv[4] = {b.x, b.y, b.z, b.w};
#pragma unroll
            for (int i = 0; i < 4; ++i)
#pragma unroll
                for (int j = 0; j < 4; ++j) acc[i][j] += av[i] * bv[j];
        }
        __syncthreads();
    }
#pragma unroll
    for (int i = 0; i < 4; ++i) {
        const int r = m0 + ty * 4 + i; float4 o = {acc[i][0], acc[i][1], acc[i][2], acc[i][3]};
        if (MODE == 1) { const float* rr = (r < rows_a) ? Ra + (size_t)r * N : Rb + (size_t)(r - rows_a) * N; const float4 x = *(const float4*)(rr + n0 + tx * 4);
            o.x += x.x; o.y += x.y; o.z += x.z; o.w += x.w; }
        if (MODE == 2) { o.x = fmaxf(o.x, 0.f); o.y = fmaxf(o.y, 0.f); o.z = fmaxf(o.z, 0.f); o.w = fmaxf(o.w, 0.f); o.x *= o.x; o.y *= o.y; o.z *= o.z; o.w *= o.w; }
        *(float4*)(C + (size_t)r * N + n0 + tx * 4) = o;
    }
}

__global__ void __launch_bounds__(256) k_conv(const float* Z, const float* state, const float* cw, float* MIX, float* out) {
    const size_t idx = (size_t)blockIdx.x * 256 + threadIdx.x;
    const int r = (int)(idx >> 9), ch = (int)(idx & 511);
    if (r >= M) return;
    const float* zr = Z + (size_t)r * DIN;
    const float cu0 = zr[C_C + ch] * zr[C_U + ch];
    float e[3]; e[2] = cu0;
    int t, T; const float* st = nullptr;
    if (r < MP) { t = r % SEQ; T = SEQ; } else { const int q = r - MP; t = q % DEC_S; T = DEC_S; st = state + (size_t)(q / DEC_S) * 2 * 512; }
#pragma unroll
    for (int j = 0; j < 2; ++j) {
        const int ei = t + j; float v;
        if (ei < 2) v = st ? st[ei * 512 + ch] : 0.f;
        else { const float* zz = Z + (size_t)(r - 2 + j) * DIN; v = zz[C_C + ch] * zz[C_U + ch]; }
        e[j] = v;
    }
    const float y = e[0] * cw[ch] + e[1] * cw[512 + ch] + e[2] * cw[1024 + ch];
    MIX[(size_t)r * D + ch] = zr[C_B + ch] * y;
    if (r < MP) { out[O_KP + (size_t)r * 512 + ch] = zr[C_K + ch]; out[O_VP + (size_t)r * 512 + ch] = zr[C_V + ch];
        if (t >= T - 2) out[O_CP + ((size_t)(r / SEQ) * 2 + (t - (T - 2))) * 512 + ch] = cu0; }
    else { const int q = r - MP; out[O_KS + (size_t)q * 512 + ch] = zr[C_K + ch]; out[O_VS + (size_t)q * 512 + ch] = zr[C_V + ch];
        if (t >= T - 2) out[O_CS + ((size_t)(q / DEC_S) * 2 + (t - (T - 2))) * 512 + ch] = cu0; }
}

__global__ void __launch_bounds__(256) k_attn(const float* Z, const float* ck, const float* cv, const int* pt, const float* lq1, const float* lk1, const float* lq2, const float* lk2,
                                              const float* subg, float* MIX, int row_lo, int nrows) {
    __shared__ float qs[4][128];
    const int wv = threadIdx.x >> 6, lane = threadIdx.x & 63;
    const int task = blockIdx.x * 4 + wv;
    if (task >= nrows * 4) return;
    const int r = row_lo + (task >> 2), h = task & 3;
    const float lam = __expf(wave_sum(lq1[lane] * lk1[lane])) - __expf(wave_sum(lq2[lane] * lk2[lane])) + 0.2f;
    const float slope = exp2f(-2.f * (h + 1));
    const bool dec = r >= MP;
    int qpos, bd = 0, rowbase;
    if (!dec) { qpos = r % SEQ; rowbase = r - qpos; } else { const int q = r - MP; bd = q / DEC_S; qpos = PAST + q % DEC_S; rowbase = MP + bd * DEC_S - PAST; }
    qs[wv][lane] = Z[(size_t)r * DIN + C_Q + h * 128 + lane]; qs[wv][64 + lane] = Z[(size_t)r * DIN + C_Q + h * 128 + 64 + lane];
    __builtin_amdgcn_s_waitcnt(0);
    float m1 = -1e30f, m2 = -1e30f, l1 = 0.f, l2 = 0.f, a1x = 0.f, a1y = 0.f, a2x = 0.f, a2y = 0.f;
    for (int j0 = 0; j0 <= qpos; j0 += 64) {
        const int j = j0 + lane; const bool valid = j <= qpos;
        float s1 = -1e30f, s2 = -1e30f;
        if (valid) {
            const float* kp;
            if (dec && j < PAST) { const int pg = pt[bd * NPAGES + j / PAGE]; kp = ck + (((size_t)pg * PAGE + (j % PAGE)) * 4 + h) * 128; }
            else kp = Z + (size_t)(rowbase + j) * DIN + C_K + h * 128;
            float d1 = 0.f, d2 = 0.f;
#pragma unroll 4
            for (int d = 0; d < 64; d += 4) { const float4 ka = *(const float4*)(kp + d), kb = *(const float4*)(kp + 64 + d);
                d1 += qs[wv][d] * ka.x + qs[wv][d + 1] * ka.y + qs[wv][d + 2] * ka.z + qs[wv][d + 3] * ka.w;
                d2 += qs[wv][64 + d] * kb.x + qs[wv][64 + d + 1] * kb.y + qs[wv][64 + d + 2] * kb.z + qs[wv][64 + d + 3] * kb.w; }
            const float bias = -slope * (float)(qpos - j);
            s1 = d1 * 0.125f + bias; s2 = d2 * 0.125f + bias;
        }
        const float n1 = fmaxf(m1, wave_max(s1)), n2 = fmaxf(m2, wave_max(s2));
        const float f1 = __expf(m1 - n1), f2 = __expf(m2 - n2);
        const float p1 = valid ? __expf(s1 - n1) : 0.f, p2 = valid ? __expf(s2 - n2) : 0.f;
        l1 = l1 * f1 + wave_sum(p1); l2 = l2 * f2 + wave_sum(p2);
        a1x *= f1; a1y *= f1; a2x *= f2; a2y *= f2; m1 = n1; m2 = n2;
        const int jn = min(64, qpos - j0 + 1);
        for (int jj = 0; jj < jn; ++jj) {
            const int jk = j0 + jj; const float* vp;
            if (dec && jk < PAST) { const int pg = pt[bd * NPAGES + jk / PAGE]; vp = cv + (((size_t)pg * PAGE + (jk % PAGE)) * 4 + h) * 128; }
            else vp = Z + (size_t)(rowbase + jk) * DIN + C_V + h * 128;
            const float2 v = *(const float2*)(vp + 2 * lane);
            const float q1 = __shfl(p1, jj), q2 = __shfl(p2, jj);
            a1x += q1 * v.x; a1y += q1 * v.y; a2x += q2 * v.x; a2y += q2 * v.y;
        }
    }
    const float ox = a1x / l1 - lam * (a2x / l2), oy = a1y / l1 - lam * (a2y / l2);
    const float rr = rsqrtf(wave_sum(ox * ox + oy * oy) * (1.f / 128.f) + EPS) * 0.8f;
    float2 o; o.x = ox * rr * subg[2 * lane]; o.y = oy * rr * subg[2 * lane + 1];
    *(float2*)(MIX + (size_t)r * D + 512 + h * 128 + 2 * lane) = o;
}
}

extern "C" void kernel_launch(void* const* d_in, const int* in_sizes, int n_in, void* d_out, int out_size, void* d_ws, size_t ws_size, hipStream_t stream) {
    const float* x_p = (const float*)d_in[0]; const float* x_s = (const float*)d_in[1];
    const float* ck = (const float*)d_in[2]; const float* cv = (const float*)d_in[3]; const float* st = (const float*)d_in[4];
    const int* pt = (const int*)d_in[5];
    const float* g1 = (const float*)d_in[6]; const float* w_in = (const float*)d_in[7]; const float* cw = (const float*)d_in[8];
    const float* lq1 = (const float*)d_in[9]; const float* lk1 = (const float*)d_in[10]; const float* lq2 = (const float*)d_in[11]; const float* lk2 = (const float*)d_in[12];
    const float* subg = (const float*)d_in[13]; const float* w_out = (const float*)d_in[14]; const float* g2 = (const float*)d_in[15];
    const float* w_up = (const float*)d_in[16]; const float* w_down = (const float*)d_in[17]; const float* gf = (const float*)d_in[18];
    float* out = (float*)d_out; float* ws = (float*)d_ws;
    float* XN = ws;
    float* Z = XN + (size_t)M * D;
    float* MIX = Z + (size_t)M * DIN;
    float* X1 = MIX + (size_t)M * D;
    float* HF = X1 + (size_t)M * D;
    float* X2 = HF + (size_t)M * FF;
    k_rmsnorm<<<M / 4, 256, 0, stream>>>(x_p, x_s, MP, g1, XN, M);
    k_gemm<0><<<dim3(DIN / 64, M / 64), 256, 0, stream>>>(XN, w_in, Z, M, DIN, D, nullptr, nullptr, 0);
    k_conv<<<(M * 512) / 256, 256, 0, stream>>>(Z, st, cw, MIX, out);
    k_attn<<<M, 256, 0, stream>>>(Z, ck, cv, pt, lq1, lk1, lq2, lk2, subg, MIX, 0, M);
    k_gemm<1><<<dim3(D / 64, M / 64), 256, 0, stream>>>(MIX, w_out, X1, M, D, D, x_p, x_s, MP);
    k_rmsnorm<<<M / 4, 256, 0, stream>>>(X1, X1, M, g2, XN, M);
    k_gemm<2><<<dim3(FF / 64, M / 64), 256, 0, stream>>>(XN, w_up, HF, M, FF, D, nullptr, nullptr, 0);
    k_gemm<1><<<dim3(D / 64, M / 64), 256, 0, stream>>>(HF, w_down, X2, M, D, FF, X1, X1, M);
    k_rmsnorm<<<M / 4, 256, 0, stream>>>(X2, X2, M, gf, out + O_Y, M);
}
```

```cpp
#include <hip/hip_runtime.h>
#include <cstdio>
#include <cstdint>

namespace pg8 {
#define PG8_LAS __attribute__((address_space(3)))
typedef unsigned short bf16_t;
typedef short bf16x8 __attribute__((ext_vector_type(8)));
typedef float f32x4 __attribute__((ext_vector_type(4)));
typedef unsigned u32x4 __attribute__((ext_vector_type(4)));
constexpr int BM = 256, BK = 64, HALF = 128, HTB = HALF * BK * 2  , STAGE_BYTES = 8 * HTB, NXCD = 8, WGM = 8;

__host__ __device__ __forceinline__ int lds_byte(int r, int c) { const int st = (r >> 4) * 2 + (c >> 5), rr = r & 15, cc = c & 31, ob = rr * 64 + cc * 2; return st * 1024 + (ob ^ (((ob >> 9) & 1) << 5)); }
__host__ __device__ __forceinline__ void stage_rc(int b, int& R, int& C) { const int st = b / 1024, sb = b % 1024, swz = sb ^ (((sb >> 9) & 1) << 5); R = (st >> 1) * 16 + swz / 64; C = (st & 1) * 32 + (swz % 64) / 2; }
__host__ __device__ __forceinline__ int perm32(int rho) { const int n = rho >> 4, i = rho & 15; return 8 * (i >> 2) + 4 * n + (i & 3); }

struct Unit { int pm, pn; };
struct Gemm { const bf16_t* A; const bf16_t* Bt; int M, N, K; };

struct StaticOrder {
    int nM, nN, nwg, G, c;
    __host__ __device__ void init(int M, int N, int G_, int c_) { nM = M / BM; nN = N / BM; nwg = nM * nN; G = G_; c = c_; }
    __host__ __device__ bool next(int i, Unit& u) const {
        const long L = (long)i * G + c; if (L >= nwg) return false;
        int wgid = (int)L; { const int q = nwg / NXCD, r = nwg % NXCD, xcd = wgid % NXCD, off = wgid / NXCD; wgid = (xcd < r ? xcd * (q + 1) : r * (q + 1) + (xcd - r) * q) + off; }
        const int nig = WGM * nN, gid = wgid / nig, fm = gid * WGM, gsz = (nM - fm) < WGM ? (nM - fm) : WGM;
        u.pm = fm + ((wgid % nig) % gsz); u.pn = (wgid % nig) / gsz; return true;
    }
    __device__ __forceinline__ void a_ready(const Unit&) const {}
    __device__ __forceinline__ void done(const Unit&) const {}
};


__device__ __forceinline__ unsigned cvt_pk_bf16(float lo, float hi) { unsigned r; asm volatile("v_cvt_pk_bf16_f32 %0, %1, %2" : "=v"(r) : "v"(lo), "v"(hi)); return r; }
typedef float f32x2 __attribute__((ext_vector_type(2)));

typedef float f32x2 __attribute__((ext_vector_type(2)));
constexpr int ROWS_P = 16384;
struct EpiInProj {
    static constexpr bool PERM = true, AFTER_DRAIN = false;
    bf16_t* planes; size_t plane_elems; float* okp; float* ovp; float* oks; float* ovs; float qscale;
    __device__ __forceinline__ void operator()(const f32x4 (&acc)[2][2][4][2], const Unit& u, int wr, int wc, int fr, int fq) const {
        const int t = u.pn >> 1; const int colb = (u.pn & 1) * 256 + wc * 32 + 8 * fq;
        const float sc = (t == 3) ? qscale : 1.f;
        bf16_t* pb = planes + (size_t)t * plane_elems;
        float* ob = nullptr;
        if (t == 4) ob = (u.pm < ROWS_P / BM) ? okp : oks - (size_t)ROWS_P * 512;
        if (t == 5) ob = (u.pm < ROWS_P / BM) ? ovp : ovs - (size_t)ROWS_P * 512;
        const int row0 = u.pm * BM + wr * 64 + fr;
#pragma unroll
        for (int ai = 0; ai < 2; ++ai)
#pragma unroll
            for (int m = 0; m < 4; ++m) { const size_t ro = (size_t)(row0 + ai * HALF + m * 16) * 512 + colb;
#pragma unroll
                for (int bj = 0; bj < 2; ++bj) { const f32x4 v0 = acc[ai][bj][m][0], v1 = acc[ai][bj][m][1];
                    if (ob) { *(f32x4*)(ob + ro + bj * HALF) = v0; *(f32x4*)(ob + ro + bj * HALF + 4) = v1; }
                    u32x4 w; w.x = cvt_pk_bf16(v0[0] * sc, v0[1] * sc); w.y = cvt_pk_bf16(v0[2] * sc, v0[3] * sc); w.z = cvt_pk_bf16(v1[0] * sc, v1[1] * sc); w.w = cvt_pk_bf16(v1[2] * sc, v1[3] * sc);
                    *(u32x4*)(pb + ro + bj * HALF) = w; } }
    }
};
template <bool WRITE_BF> struct EpiResid {
    static constexpr bool PERM = true, AFTER_DRAIN = false;
    const float* base_p; const float* base_s;
    float* out; bf16_t* outb; float* ssq;
    __device__ __forceinline__ void operator()(const f32x4 (&acc)[2][2][4][2], const Unit& u, int wr, int wc, int fr, int fq) const {
        const int col0 = u.pn * BM + wc * 32 + 8 * fq; const int row0 = u.pm * BM + wr * 64 + fr;
        const float* bb = (u.pm < ROWS_P / BM) ? base_p : base_s - (size_t)ROWS_P * 1024;
#pragma unroll
        for (int ai = 0; ai < 2; ++ai)
#pragma unroll
            for (int m = 0; m < 4; ++m) { const int row = row0 + ai * HALF + m * 16; const size_t ro = (size_t)row * 1024 + col0; float s = 0.f;
#pragma unroll
                for (int bj = 0; bj < 2; ++bj) { const f32x4 x0 = *(const f32x4*)(bb + ro + bj * HALF), x1 = *(const f32x4*)(bb + ro + bj * HALF + 4);
                    const f32x4 v0 = acc[ai][bj][m][0] + x0, v1 = acc[ai][bj][m][1] + x1;
                    *(f32x4*)(out + ro + bj * HALF) = v0; *(f32x4*)(out + ro + bj * HALF + 4) = v1;
                    if (WRITE_BF) { u32x4 w; w.x = cvt_pk_bf16(v0[0], v0[1]); w.y = cvt_pk_bf16(v0[2], v0[3]); w.z = cvt_pk_bf16(v1[0], v1[1]); w.w = cvt_pk_bf16(v1[2], v1[3]); *(u32x4*)(outb + ro + bj * HALF) = w; }
                    s += (v0[0] * v0[0] + v0[1] * v0[1]) + (v0[2] * v0[2] + v0[3] * v0[3]) + (v1[0] * v1[0] + v1[1] * v1[1]) + (v1[2] * v1[2] + v1[3] * v1[3]); }
                s += __shfl_xor(s, 16); s += __shfl_xor(s, 32);
                if (fq == 0) ssq[(size_t)row * 16 + u.pn * 4 + wc] = s; }
    }
};
struct EpiUp {
    static constexpr bool PERM = true, AFTER_DRAIN = false;
    bf16_t* O; int ldc; const float* ssq; float eps;
    __device__ __forceinline__ void operator()(const f32x4 (&acc)[2][2][4][2], const Unit& u, int wr, int wc, int fr, int fq) const {
        const int col0 = u.pn * BM + wc * 32 + 8 * fq; const int row0 = u.pm * BM + wr * 64 + fr;
#pragma unroll
        for (int ai = 0; ai < 2; ++ai)
#pragma unroll
            for (int m = 0; m < 4; ++m) { const int row = row0 + ai * HALF + m * 16; const f32x4* sp = (const f32x4*)(ssq + (size_t)row * 16);
                const f32x4 a = sp[0], b = sp[1], c = sp[2], d = sp[3];
                const float tot = (((a[0] + a[1]) + (a[2] + a[3])) + ((b[0] + b[1]) + (b[2] + b[3]))) + (((c[0] + c[1]) + (c[2] + c[3])) + ((d[0] + d[1]) + (d[2] + d[3])));
                const float rstd = 1.0f / sqrtf(tot * (1.0f / 1024.0f) + eps);
                bf16_t* rowp = O + (size_t)row * ldc + col0;
#pragma unroll
                for (int bj = 0; bj < 2; ++bj) { f32x4 v0 = acc[ai][bj][m][0] * rstd, v1 = acc[ai][bj][m][1] * rstd;
#pragma unroll
                    for (int e = 0; e < 4; ++e) { v0[e] = fmaxf(v0[e], 0.f); v0[e] *= v0[e]; v1[e] = fmaxf(v1[e], 0.f); v1[e] *= v1[e]; }
                    u32x4 w; w.x = cvt_pk_bf16(v0[0], v0[1]); w.y = cvt_pk_bf16(v0[2], v0[3]); w.z = cvt_pk_bf16(v1[0], v1[1]); w.w = cvt_pk_bf16(v1[2], v1[3]);
                    *(u32x4*)(rowp + bj * HALF) = w; } }
    }
};

template <class Epi, class Sched, bool ALIGN_EPI = false, bool SP2 = false>
__device__ __forceinline__ void gemm_phase(PG8_LAS unsigned char* lds, const Gemm g, const Sched& S, const Epi& E) {
    int tid_ = threadIdx.x; asm volatile("" : "+v"(tid_));
    const int tid = tid_, wid = __builtin_amdgcn_readfirstlane(tid >> 6), lane = tid & 63, wr = wid >> 2, wc = wid & 3, fr = lane & 15, fq = lane >> 4;
    const int K = g.K, nt = K / BK;
    unsigned voffA[2], voffB[2];
#pragma unroll
    for (int i = 0; i < 2; ++i) { int R, C; stage_rc(tid * 16 + i * 8192, R, C); const int Rb = Epi::PERM ? ((R & ~31) + perm32(R & 31)) : R;
        voffA[i] = (unsigned)(R * K + C) * 2u; voffB[i] = (unsigned)(Rb * K + C) * 2u; }
    const size_t kstep = (size_t)(BK * 2);
    const size_t hstep = (size_t)HALF * K * 2;
    const size_t tstep = 2 * hstep;
    const unsigned ldsw = (unsigned)wid * 1024u;
    const int aoff = lds_byte(wr * 64 + fr, fq * 8), boff = lds_byte(wc * 32 + fr, fq * 8);
#define PG8_SA(b, h) (((b) * 2 + (h)) * HTB)
#define PG8_SB(b, h) ((4 + (b) * 2 + (h)) * HTB)
#define PG8_STAGE(bufoff, gbase, voff) do { _Pragma("unroll") for (int _i = 0; _i < 2; ++_i) \
        __builtin_amdgcn_global_load_lds((const unsigned*)((const char*)(gbase) + (voff)[_i]), (PG8_LAS unsigned*)(lds + (bufoff) + ldsw + _i * 8192), 16, 0, 0); } while (0)
#define PG8_LDA(dst, b, h) do { _Pragma("unroll") for (int m = 0; m < 4; ++m) _Pragma("unroll") for (int k = 0; k < 2; ++k) dst[m][k] = *(const PG8_LAS bf16x8*)(lds + PG8_SA(b, h) + aoff + m * 2048 + k * 1024); } while (0)
#define PG8_LDB(dst, b, h) do { _Pragma("unroll") for (int n = 0; n < 2; ++n) _Pragma("unroll") for (int k = 0; k < 2; ++k) dst[n][k] = *(const PG8_LAS bf16x8*)(lds + PG8_SB(b, h) + boff + n * 2048 + k * 1024); } while (0)
#define PG8_MMA(ai, bj, At, Bt) do { __builtin_amdgcn_s_setprio(1); _Pragma("unroll") for (int m = 0; m < 4; ++m) _Pragma("unroll") for (int n = 0; n < 2; ++n) _Pragma("unroll") for (int k = 0; k < 2; ++k) \
        acc[ai][bj][m][n] = __builtin_amdgcn_mfma_f32_16x16x32_bf16(Bt[n][k], At[m][k], acc[ai][bj][m][n], 0, 0, 0); __builtin_amdgcn_s_setprio(0); } while (0)
#define PG8_WAIT_V(n) asm volatile("s_waitcnt vmcnt(" #n ")" ::: "memory")
#define PG8_WAIT_L(n) asm volatile("s_waitcnt lgkmcnt(" #n ")" ::: "memory")
#define PG8_BAR __builtin_amdgcn_s_barrier()
#define PG8_SCHED __builtin_amdgcn_sched_barrier(0)
    Unit cur, nxt; int ui = 0;
    if (!S.next(0, cur)) return;
    f32x4 acc[2][2][4][2];
#pragma unroll
    for (int a = 0; a < 2; ++a)
#pragma unroll
        for (int b = 0; b < 2; ++b)
#pragma unroll
            for (int m = 0; m < 4; ++m)
#pragma unroll
                for (int n = 0; n < 2; ++n) acc[a][b][m][n] = (f32x4){0.f, 0.f, 0.f, 0.f};
    bf16x8 At[4][2], B0[2][2], B1[2][2];
    const char* cA = (const char*)g.A + (size_t)cur.pm * tstep; const char* cB = (const char*)g.Bt + (size_t)cur.pn * tstep;
    S.a_ready(cur);
    if constexpr (SP2) {
        PG8_STAGE(PG8_SB(0, 0), cB, voffB); PG8_STAGE(PG8_SB(0, 1), cB + hstep, voffB); PG8_STAGE(PG8_SA(0, 0), cA, voffA); PG8_STAGE(PG8_SA(0, 1), cA + hstep, voffA);
        if (wr == 1) PG8_BAR;
        PG8_WAIT_V(2); PG8_BAR;
        PG8_STAGE(PG8_SB(1, 0), cB + kstep, voffB); PG8_STAGE(PG8_SA(1, 0), cA + kstep, voffA); PG8_STAGE(PG8_SB(1, 1), cB + hstep + kstep, voffB);
        PG8_WAIT_V(6); PG8_BAR;
    } else {
        PG8_STAGE(PG8_SB(0, 0), cB, voffB); PG8_STAGE(PG8_SA(0, 0), cA, voffA); PG8_STAGE(PG8_SB(0, 1), cB + hstep, voffB); PG8_STAGE(PG8_SA(0, 1), cA + hstep, voffA);
        if (wr == 1) PG8_BAR;
        PG8_WAIT_V(4); PG8_BAR;
        PG8_STAGE(PG8_SB(1, 0), cB + kstep, voffB); PG8_STAGE(PG8_SA(1, 0), cA + kstep, voffA); PG8_STAGE(PG8_SB(1, 1), cB + hstep + kstep, voffB);
        PG8_WAIT_V(6); PG8_BAR;
    }
    for (;;) {
        const bool has_next = S.next(ui + 1, nxt);
        const char* nA = has_next ? (const char*)g.A + (size_t)nxt.pm * tstep : cA; const char* nB = has_next ? (const char*)g.Bt + (size_t)nxt.pn * tstep : cB;
        for (int t = 0; t < nt; t += 2) {
            const bool last = (t == nt - 2);
            const char* a1 = cA + (size_t)(t + 1) * kstep;
            const char* a2 = last ? nA : cA + (size_t)(t + 2) * kstep; const char* b2 = last ? nB : cB + (size_t)(t + 2) * kstep;
            const char* a3 = a2 + kstep; const char* b3 = b2 + kstep;
            if (last && has_next) S.a_ready(nxt);
            if constexpr (SP2) {
            PG8_LDB(B0, 0, 0); PG8_LDB(B1, 0, 1); PG8_SCHED; PG8_LDA(At, 0, 0); PG8_STAGE(PG8_SA(1, 1), a1 + hstep, voffA);
            PG8_WAIT_V(8); PG8_WAIT_L(0); PG8_BAR; PG8_MMA(0, 0, At, B0); PG8_MMA(0, 1, At, B1); PG8_BAR; PG8_SCHED;
            PG8_LDA(At, 0, 1); PG8_STAGE(PG8_SB(0, 0), b2, voffB); PG8_STAGE(PG8_SB(0, 1), b2 + hstep, voffB); PG8_STAGE(PG8_SA(0, 0), a2, voffA);
            PG8_WAIT_V(8); PG8_WAIT_L(0); PG8_BAR; PG8_MMA(1, 0, At, B0); PG8_MMA(1, 1, At, B1); PG8_BAR; PG8_SCHED;
            PG8_LDB(B0, 1, 0); PG8_LDB(B1, 1, 1); PG8_SCHED; PG8_LDA(At, 1, 0); PG8_STAGE(PG8_SA(0, 1), a2 + hstep, voffA);
            PG8_WAIT_V(8); PG8_WAIT_L(0); PG8_BAR; PG8_MMA(0, 0, At, B0); PG8_MMA(0, 1, At, B1); PG8_BAR; PG8_SCHED;
            PG8_LDA(At, 1, 1); PG8_STAGE(PG8_SB(1, 0), b3, voffB); PG8_STAGE(PG8_SB(1, 1), b3 + hstep, voffB); PG8_STAGE(PG8_SA(1, 0), a3, voffA);
            PG8_WAIT_V(8); PG8_WAIT_L(0); PG8_BAR; PG8_MMA(1, 0, At, B0); PG8_MMA(1, 1, At, B1); PG8_BAR; PG8_SCHED;
            } else {
            PG8_LDB(B0, 0, 0); PG8_SCHED; PG8_LDA(At, 0, 0); PG8_STAGE(PG8_SA(1, 1), a1 + hstep, voffA);
            PG8_WAIT_L(8); PG8_BAR; PG8_WAIT_L(0); PG8_MMA(0, 0, At, B0); PG8_BAR; PG8_SCHED;
            PG8_LDB(B1, 0, 1); PG8_STAGE(PG8_SB(0, 0), b2, voffB);
            PG8_BAR; PG8_WAIT_L(0); PG8_MMA(0, 1, At, B1); PG8_BAR;
            PG8_LDA(At, 0, 1); PG8_STAGE(PG8_SA(0, 0), a2, voffA);
            PG8_BAR; PG8_WAIT_L(0); PG8_MMA(1, 0, At, B0); PG8_BAR; PG8_SCHED;
            PG8_STAGE(PG8_SB(0, 1), b2 + hstep, voffB);
            PG8_WAIT_V(6); PG8_BAR; PG8_MMA(1, 1, At, B1); PG8_BAR;
            PG8_LDB(B0, 1, 0); PG8_SCHED; PG8_LDA(At, 1, 0); PG8_STAGE(PG8_SA(0, 1), a2 + hstep, voffA);
            PG8_WAIT_L(8); PG8_BAR; PG8_WAIT_L(0); PG8_MMA(0, 0, At, B0); PG8_BAR; PG8_SCHED;
            PG8_LDB(B1, 1, 1); PG8_STAGE(PG8_SB(1, 0), b3, voffB);
            PG8_BAR; PG8_WAIT_L(0); PG8_MMA(0, 1, At, B1); PG8_BAR;
            PG8_LDA(At, 1, 1); PG8_STAGE(PG8_SA(1, 0), a3, voffA);
            PG8_BAR; PG8_WAIT_L(0); PG8_MMA(1, 0, At, B0); PG8_BAR; PG8_SCHED;
            PG8_STAGE(PG8_SB(1, 1), b3 + hstep, voffB);
            PG8_WAIT_V(6); PG8_BAR; PG8_MMA(1, 1, At, B1); PG8_BAR;
            }
        }
        if constexpr (ALIGN_EPI) { if (wr == 0) PG8_BAR; }
        if constexpr (!Epi::AFTER_DRAIN) { E(acc, cur, wr, wc, fr, fq); S.done(cur); }
        if (!has_next) break;
#pragma unroll
        for (int a = 0; a < 2; ++a)
#pragma unroll
            for (int b = 0; b < 2; ++b)
#pragma unroll
                for (int m = 0; m < 4; ++m)
#pragma unroll
                    for (int n = 0; n < 2; ++n) acc[a][b][m][n] = (f32x4){0.f, 0.f, 0.f, 0.f};
        cur = nxt; cA = nA; cB = nB; ++ui;
        if constexpr (ALIGN_EPI) { if (wr == 1) PG8_BAR; }
    }
    PG8_WAIT_V(0);
    if constexpr (!ALIGN_EPI) { if (wr == 0) PG8_BAR; }
    PG8_BAR;
    if constexpr (Epi::AFTER_DRAIN) { E.fused(acc, cur, wr, wc, fr, fq, lds, wid, lane); S.done(cur); }
#undef PG8_SA
#undef PG8_SB
#undef PG8_STAGE
#undef PG8_LDA
#undef PG8_LDB
#undef PG8_MMA
#undef PG8_WAIT_V
#undef PG8_WAIT_L
#undef PG8_BAR
#undef PG8_SCHED
}
}

#define GAS __attribute__((address_space(1)))
#define LAS __attribute__((address_space(3)))
typedef unsigned short bf16;
typedef unsigned v4u __attribute__((ext_vector_type(4)));
typedef float f32x4 __attribute__((ext_vector_type(4)));
typedef short bf16x8 __attribute__((ext_vector_type(8)));
typedef GAS unsigned gu32;
typedef GAS unsigned long long gu64;
#define RLX_AGENT __ATOMIC_RELAXED, __HIP_MEMORY_SCOPE_AGENT
#define LDS_WAIT() asm volatile("s_waitcnt lgkmcnt(0)" ::: "memory")
#define VM_WAIT() asm volatile("s_waitcnt vmcnt(0)" ::: "memory")
__device__ __forceinline__ unsigned long long rt() { return __builtin_amdgcn_s_memrealtime(); }
__device__ __forceinline__ unsigned f2bf(float f) { unsigned u = __builtin_bit_cast(unsigned, f); return (u + 0x7fffu + ((u >> 16) & 1u)) >> 16; }
__device__ __forceinline__ unsigned pk2(float lo, float hi) { return f2bf(lo) | (f2bf(hi) << 16); }

#define XB_TMO      128
#define XB_XCNT(j)  (256  + 64 * (j))
#define XB_XSUB(j)  (1280 + 64 * (j))
#define XB_XGEN(j)  (2304 + 64 * (j))
#define XB_TOP      3328
#define XB_TOPGEN   3392
#define XCD_BAR_WORDS 3456
#define XB_SPIN_CAP (1u << 18)

__device__ __forceinline__ unsigned xb_ld(unsigned* p)              { return __hip_atomic_load(p, __ATOMIC_RELAXED, __HIP_MEMORY_SCOPE_AGENT); }
__device__ __forceinline__ unsigned xb_add(unsigned* p, unsigned v) { return __hip_atomic_fetch_add(p, v, __ATOMIC_RELAXED, __HIP_MEMORY_SCOPE_AGENT); }
__device__ __forceinline__ unsigned xb_xcc_id() { return (unsigned)__builtin_amdgcn_s_getreg((3 << 11) | 20) & 0xFu; }
#define XB_SPIN(cond, bar) do { unsigned _sp = 0; while (cond) { __builtin_amdgcn_s_sleep(1); \
    if ((++_sp & 255u) == 0u) { if (xb_ld(&(bar)[XB_TMO])) break; if (_sp > XB_SPIN_CAP) { atomicAdd(&(bar)[XB_TMO], 1u); break; } } } } while (0)

struct XcdBarrier {
    unsigned* bar; unsigned x;
    volatile LAS unsigned* st;
};

__device__ __forceinline__ XcdBarrier xcd_barrier_post(unsigned* bar, volatile LAS unsigned* st) {
    XcdBarrier b; b.bar = bar; b.x = xb_xcc_id(); b.st = st;
    if (threadIdx.x == 0) (void)xb_add(&bar[XB_XCNT(b.x)], 1u);
    return b;
}
__device__ __forceinline__ void xcd_barrier_complete(unsigned* bar, unsigned x, unsigned& nloc, unsigned& nx) {
    const unsigned G = gridDim.x * gridDim.y * gridDim.z;
    unsigned sum, cnt, mine, sp = 0u;
    for (;;) {
        sum = 0u; cnt = 0u; mine = 0u;
#pragma unroll
        for (unsigned j = 0; j < 16; ++j) { const unsigned c = xb_ld(&bar[XB_XCNT(j)]); sum += c; cnt += (c > 0u) ? 1u : 0u; mine = (j == x) ? c : mine; }
        if (sum == G) break;
        __builtin_amdgcn_s_sleep(1);
        if ((++sp & 255u) == 0u) { if (xb_ld(&bar[XB_TMO])) break; if (sp > XB_SPIN_CAP) { atomicAdd(&bar[XB_TMO], 1u); break; } }
    }
    nloc = mine > 0u ? mine : 1u; nx = cnt > 0u ? cnt : 1u;
}

__device__ __forceinline__ void xcd_barrier(const XcdBarrier& b) {
    asm volatile("s_waitcnt vmcnt(0)" ::: "memory");
    __syncthreads();
    if (threadIdx.x == 0) {
        unsigned* bar = b.bar;
        __builtin_amdgcn_s_waitcnt(0);
        unsigned nloc = b.st[0], nx = b.st[1];
        if (nloc == 0u) { xcd_barrier_complete(bar, b.x, nloc, nx); b.st[0] = nloc; b.st[1] = nx; }
        const unsigned old = xb_add(&bar[XB_XSUB(b.x)], 1u);
        const unsigned gen = old / nloc;
        if (old + 1u == (gen + 1u) * nloc) {
            __builtin_amdgcn_fence(__ATOMIC_RELEASE, "agent");
            asm volatile("s_waitcnt vmcnt(0)" ::: "memory");
            const unsigned og = xb_add(&bar[XB_TOP], 1u);
            const unsigned tg = og / nx;
            if (og + 1u == (tg + 1u) * nx) xb_add(&bar[XB_TOPGEN], 1u);
            else XB_SPIN(xb_ld(&bar[XB_TOPGEN]) == tg, bar);
            __builtin_amdgcn_fence(__ATOMIC_ACQUIRE, "agent");
            xb_add(&bar[XB_XGEN(b.x)], 1u);
            asm volatile("s_waitcnt vmcnt(0)" ::: "memory");
        } else {
            XB_SPIN(xb_ld(&bar[XB_XGEN(b.x)]) == gen, bar);
            __builtin_amdgcn_fence(__ATOMIC_ACQUIRE, "agent");
            asm volatile("s_waitcnt vmcnt(0)" ::: "memory");
        }
    }
    __syncthreads();
}

#include <hip/hip_bf16.h>
#include <cmath>
namespace dattn {
using bf16=__hip_bfloat16;
using bf16x8=__attribute__((ext_vector_type(8)))short;
using s16x4=__attribute__((ext_vector_type(4)))short;
using f32x16=__attribute__((ext_vector_type(16)))float;
using u32x4=__attribute__((ext_vector_type(4)))unsigned;
constexpr int SEQ=2048,D=64,DM=512;
constexpr int NW=8,QBLK=32,QB=QBLK*NW,KVBLK=64;
constexpr int OPITCH=1024;
__device__ __forceinline__ int crow(int r,int hi){return (r&3)+8*(r>>2)+4*hi;}
#define SBAR() __builtin_amdgcn_sched_barrier(0)
__device__ __forceinline__ void cmask(f32x16&p0,f32x16&p1,int jb,int qrel,int hi){
  const float NEG=-INFINITY; int kb=64*jb+4*hi;
  #pragma unroll
  for(int r=0;r<16;++r){int kv=kb+(r&3)+8*(r>>2); if(kv>qrel)p0[r]=NEG; if(kv+32>qrel)p1[r]=NEG;}
}
constexpr int NSLOT=3, SLOTB=8192;
constexpr int LDS_K=0, LDS_V=NSLOT*SLOTB, LDS_WS=2*NSLOT*SLOTB, LDS_OST=LDS_WS+NW*64*4, LDS_STA=LDS_OST+NW*4096, LDS_BYTES=LDS_STA+NW*4096;
__device__ __forceinline__ void glds16(const void*gsrc,unsigned lds_dst){unsigned keep;
  asm volatile("s_mov_b32 %0, m0\n\ts_mov_b32 m0, %2\n\ts_nop 0\n\tglobal_load_lds_dwordx4 %1, off\n\ts_mov_b32 m0, %0":"=&s"(keep):"v"(gsrc),"s"(lds_dst):"memory");}
__device__ __forceinline__ float max3f(float a,float b,float c){float r;asm("v_max3_f32 %0, %1, %2, %3":"=v"(r):"v"(a),"v"(b),"v"(c));return r;}
__device__ __forceinline__ float max2f(float a,float b){float r;asm("v_max_f32_e32 %0, %1, %2":"=v"(r):"v"(a),"v"(b));return r;}
__device__ __forceinline__ float fsub_s(float a,float b){float r;asm("v_sub_f32_e32 %0, %1, %2":"=v"(r):"v"(a),"v"(b));return r;}
typedef float f32x2_t __attribute__((ext_vector_type(2))); typedef __bf16 bf16x2_t __attribute__((ext_vector_type(2)));
__device__ __forceinline__ unsigned cvtpk_s(float lo,float hi){f32x2_t v={lo,hi};bf16x2_t b=__builtin_convertvector(v,bf16x2_t);return __builtin_bit_cast(unsigned,b);}
#define WAIT_BAR(N) asm volatile("s_waitcnt vmcnt(" #N ") lgkmcnt(0)\n\ts_barrier":::"memory")
__device__ __forceinline__ void bias_init(f32x16&x,float a,float s2){
  #pragma unroll
  for(int r=0;r<16;++r)x[r]=__builtin_fmaf(s2,(float)((r&3)+8*(r>>2)),a);
}
__device__ __forceinline__ void qkt(f32x16&p0,f32x16&p1,const char*Kslot,const bf16x8*qr,int r32,int hi){
  const char*kb=Kslot+hi*1024+r32*16;
  #pragma unroll
  for(int d0=0;d0<4;++d0){
    const bf16x8 b0=*reinterpret_cast<const bf16x8*>(kb+d0*2048);
    const bf16x8 b1=*reinterpret_cast<const bf16x8*>(kb+d0*2048+512);
    p0=__builtin_amdgcn_mfma_f32_32x32x16_bf16(b0,qr[d0],p0,0,0,0);p1=__builtin_amdgcn_mfma_f32_32x32x16_bf16(b1,qr[d0],p1,0,0,0);}
}
typedef __attribute__((address_space(3))) const char* lds_cptr;
typedef short v4i16_t __attribute__((ext_vector_type(4)));
__device__ __forceinline__ void kload8(bf16x8*kf,lds_cptr kp){
  kf[0]=*(const __attribute__((address_space(3))) bf16x8*)(kp);      kf[1]=*(const __attribute__((address_space(3))) bf16x8*)(kp+512);
  kf[2]=*(const __attribute__((address_space(3))) bf16x8*)(kp+2048); kf[3]=*(const __attribute__((address_space(3))) bf16x8*)(kp+2560);
  kf[4]=*(const __attribute__((address_space(3))) bf16x8*)(kp+4096); kf[5]=*(const __attribute__((address_space(3))) bf16x8*)(kp+4608);
  kf[6]=*(const __attribute__((address_space(3))) bf16x8*)(kp+6144); kf[7]=*(const __attribute__((address_space(3))) bf16x8*)(kp+6656);
}
__device__ __forceinline__ void kload2(bf16x8*kf,lds_cptr kp,int j){ kf[2*j]=*(const __attribute__((address_space(3))) bf16x8*)(kp+j*2048); kf[2*j+1]=*(const __attribute__((address_space(3))) bf16x8*)(kp+j*2048+512); }
__device__ __forceinline__ s16x4 vtr(lds_cptr p){ return __builtin_bit_cast(s16x4,__builtin_amdgcn_ds_read_tr16_b64_v4i16((__attribute__((address_space(3))) v4i16_t*)p)); }
__device__ __forceinline__ float rowmax(const f32x16&p0,const f32x16&p1){
  float a=max3f(p0[0],p0[1],p1[0]),b=max3f(p0[2],p0[3],p1[1]);a=max3f(a,p1[2],p1[3]);
  #pragma unroll
  for(int r=4;r<16;r+=4){a=max3f(a,p0[r],p0[r+1]);b=max3f(b,p0[r+2],p0[r+3]);a=max3f(a,p1[r],p1[r+1]);b=max3f(b,p1[r+2],p1[r+3]);}
  const float m=max2f(a,b);
  auto rr=__builtin_amdgcn_permlane32_swap(__float_as_uint(m),__float_as_uint(m),false,false);
  return max2f(__uint_as_float(rr[0]),__uint_as_float(rr[1]));
}
__device__ __forceinline__ void pv(f32x16*o,int vb,bf16x8 pa0,bf16x8 pa1,bf16x8 pa2,bf16x8 pa3){
  #pragma unroll
  for(int d0=0;d0<2;++d0){s16x4 lo[4],hi[4];
    #pragma unroll
    for(int ks=0;ks<4;++ks){
      asm volatile("ds_read_b64_tr_b16 %0,%1 offset:%c2":"=&v"(lo[ks]):"v"(vb),"i"(d0*4096+ks*1024):"memory");
      asm volatile("ds_read_b64_tr_b16 %0,%1 offset:%c2":"=&v"(hi[ks]):"v"(vb),"i"(d0*4096+ks*1024+512):"memory");}
    asm volatile("s_waitcnt lgkmcnt(0)":::"memory");SBAR();
    #define PK(k) (bf16x8){lo[k][0],lo[k][1],lo[k][2],lo[k][3],hi[k][0],hi[k][1],hi[k][2],hi[k][3]}
    o[d0]=__builtin_amdgcn_mfma_f32_32x32x16_bf16(pa0,PK(0),o[d0],0,0,0);
    o[d0]=__builtin_amdgcn_mfma_f32_32x32x16_bf16(pa1,PK(1),o[d0],0,0,0);
    o[d0]=__builtin_amdgcn_mfma_f32_32x32x16_bf16(pa2,PK(2),o[d0],0,0,0);
    o[d0]=__builtin_amdgcn_mfma_f32_32x32x16_bf16(pa3,PK(3),o[d0],0,0,0);
    #undef PK
  }
}
__device__ __forceinline__ float half_sum(float v){
  #pragma unroll
  for(int o=1;o<32;o<<=1)v+=__shfl_xor(v,o);
  return v;
}

template<int THRL> __device__ __forceinline__ void attn_sub(int b,int h,int qb,int sub,const bf16*PQ,const bf16*__restrict__ PK,const bf16*__restrict__ PV,unsigned short*MIX,float lam,const float*subg,char*shm){
  int tid_=threadIdx.x; asm volatile("":"+v"(tid_));
  const int tid=tid_,lane=tid&63,r32=lane&31,hi=lane>>5; const int wid=__builtin_amdgcn_readfirstlane(tid>>6);
  const int c=sub&1,vh=sub>>1;
  const long rowbase=(long)b*SEQ; const int q0=qb*QB;
  const bf16*Qw=PQ+(rowbase+q0+wid*QBLK)*DM+h*128+c*64;
  const bf16*Kh=PK+rowbase*DM+h*128+c*64,*Vh=PV+rowbase*DM+h*128+vh*64;
  const unsigned lds0=(unsigned)(uintptr_t)shm;
  float*wsf=(float*)(shm+LDS_WS)+wid*64;
  const int NT=(q0+QB)/KVBLK;
  const bf16*ksrc=Kh+(long)lane*DM+wid*8+(long)(NT-1)*KVBLK*DM;
  const bf16*vsrc=Vh+(long)(16*(wid&3)+(lane>>2))*DM+(wid>>2)*32+(lane&3)*8+(long)(NT-1)*KVBLK*DM;
  const unsigned kdst=lds0+LDS_K+wid*1024, vdst=lds0+LDS_V+wid*1024;
  #define DMA_K(t,slot) glds16(ksrc-(long)(t)*KVBLK*DM,(unsigned)__builtin_amdgcn_readfirstlane(kdst+(slot)))
  #define DMA_V(t,slot) glds16(vsrc-(long)(t)*KVBLK*DM,(unsigned)__builtin_amdgcn_readfirstlane(vdst+(slot)))
  const int vb0=(int)(lds0+LDS_V)+((lane>>4)&1)*32+(lane&3)*8+(4*hi+((lane&15)>>2))*64;
  const char*Kbase=shm+LDS_K; bf16x8 kf[8];
  const lds_cptr shm3=(lds_cptr)shm; const lds_cptr kp0=shm3+LDS_K+hi*1024+r32*16; const lds_cptr vp0=shm3+LDS_V+((lane>>4)&1)*32+(lane&3)*8+(4*hi+((lane&15)>>2))*64;
  DMA_K(0,0);DMA_V(0,0);DMA_K(1,SLOTB);
  bf16x8 qr[4];
  #pragma unroll
  for(int d0=0;d0<4;++d0)qr[d0]=*reinterpret_cast<const bf16x8*>(&Qw[(long)r32*DM+d0*16+hi*8]);
  float mhat=0.f,l_reg=0.f;f32x16 o[2];o[0]=f32x16{};o[1]=f32x16{};
  const int qrel=wid*QBLK+r32;
  const float s2=__builtin_amdgcn_exp2f(-2.f*(float)(h+1))*1.4426950408889634f;
  const float ab0=s2*(float)(192+4*hi-qrel);
  #define CMASK(P0,P1,t) do{int jb_=3-(t); if(jb_>=0)cmask(P0,P1,jb_,qrel,hi);}while(0)
  bool resc=false;
  #define RESC() do{ if(resc){ asm volatile("s_waitcnt lgkmcnt(0)":::"memory"); \
      _Pragma("unroll") for(int d_=0;d_<2;++d_) _Pragma("unroll") for(int r=0;r<16;++r)o[d_][r]*=wsf[crow(r,hi)]; } }while(0)
  f32x16 pA0,pA1,pB0,pB1;
  int sl_prev=0,sl_cur=0,sl_next=SLOTB;
  #define ROT() do{sl_prev=sl_cur;sl_cur=sl_next;sl_next=(sl_next==(NSLOT-1)*SLOTB)?0:sl_next+SLOTB;}while(0)
  DMA_K(2,2*SLOTB);
  WAIT_BAR(3);
  bias_init(pA0,ab0,s2); bias_init(pA1,ab0+32.f*s2,s2);
  qkt(pA0,pA1,Kbase,qr,r32,hi);asm volatile("s_nop 15\n\ts_nop 7":"+v"(pA0),"+v"(pA1));CMASK(pA0,pA1,0);
  { const float rm=rowmax(pA0,pA1); const float dl=__builtin_fmaxf(rm,-1024.f); mhat=dl;
    _Pragma("unroll") for(int r=0;r<16;++r){pA0[r]=fsub_s(pA0[r],dl);pA1[r]=fsub_s(pA1[r],dl);}
    _Pragma("unroll") for(int r=0;r<16;++r)pA0[r]=__builtin_amdgcn_exp2f(pA0[r]); }
  _Pragma("unroll") for(int r=0;r<16;++r)pA1[r]=__builtin_amdgcn_exp2f(pA1[r]);
  WAIT_BAR(0);
  DMA_K(3,0);DMA_V(1,SLOTB);
  ROT();
  kload8(kf,kp0+sl_cur);
  WAIT_BAR(2);
  s16x4 vlo[8],vhi[8]; u32x4 pw0,pw1,pw2,pw3;
  #define PKW(P,B) cvtpk_s(P[B],P[B+1])
  #define PAF(k) __builtin_bit_cast(bf16x8,pw##k)
  #define VFR(i) (bf16x8){vlo[i][0],vlo[i][1],vlo[i][2],vlo[i][3],vhi[i][0],vhi[i][1],vhi[i][2],vhi[i][3]}
  #define PIN(x) asm volatile("":"+v"(x))
  #define MX3(a,b,c) __builtin_fmaxf(__builtin_fmaxf((a),(b)),(c))
  #define GAPA(MF,A0,A1,A2,A3,W0,W1,PW) do{ MF; sacc+=A0; sacc+=A1; sacc+=A2; sacc+=A3; PIN(sacc); W0; W1; PIN(PW); SBAR(); }while(0)
  #define EX(v) __builtin_amdgcn_exp2f(v)
  #define GAPB(MF,X,B) do{ MF; X[B]=EX(X[B]); X[B+1]=EX(X[B+1]); X[B+2]=EX(X[B+2]); X[B+3]=EX(X[B+3]); PIN(X); SBAR(); }while(0)
  #define VRD(i) do{ vlo[i]=vtr(vp_+(((i)>>2)*4096+((i)&3)*1024)); vhi[i]=vtr(vp_+(((i)>>2)*4096+((i)&3)*1024+512)); }while(0)
  #define KRD(G,j) do{ if(G){ kload2(kf,kp0+sl_next,j); SBAR(); } }while(0)
  #define STEP(C0,C1,P0,P1,t,GK,GV,GL) do{ SBAR(); \
    const lds_cptr vp_=vp0+sl_prev; \
    const float a0_=__builtin_fmaf(-64.f*s2,(float)(t),ab0)-mhat; \
    bias_init(C0,a0_,s2); bias_init(C1,a0_+32.f*s2,s2); SBAR(); \
    VRD(0); SBAR(); float sacc=(P0[0]+P0[1]); \
    GAPA(C0=__builtin_amdgcn_mfma_f32_32x32x16_bf16(kf[0],qr[0],C0,0,0,0), P0[2],P0[3],P0[4],P0[5],     pw0[0]=PKW(P0,0), pw0[1]=PKW(P0,2), pw0); \
    VRD(4); SBAR(); GAPA(C1=__builtin_amdgcn_mfma_f32_32x32x16_bf16(kf[1],qr[0],C1,0,0,0), P0[6],P0[7],P0[8],P0[9],     pw0[2]=PKW(P0,4), pw0[3]=PKW(P0,6), pw0); \
    VRD(1); SBAR(); GAPA(C0=__builtin_amdgcn_mfma_f32_32x32x16_bf16(kf[2],qr[1],C0,0,0,0),   P0[10],P0[11],P0[12],P0[13], pw1[0]=PKW(P0,8), pw1[1]=PKW(P0,10), pw1); \
    VRD(5); SBAR(); GAPA(C1=__builtin_amdgcn_mfma_f32_32x32x16_bf16(kf[3],qr[1],C1,0,0,0),   P0[14],P0[15],P1[0],P1[1],   pw1[2]=PKW(P0,12),pw1[3]=PKW(P0,14), pw1); \
    VRD(2); SBAR(); GAPA(C0=__builtin_amdgcn_mfma_f32_32x32x16_bf16(kf[4],qr[2],C0,0,0,0),   P1[2],P1[3],P1[4],P1[5],     pw2[0]=PKW(P1,0), pw2[1]=PKW(P1,2), pw2); \
    VRD(6); SBAR(); GAPA(C1=__builtin_amdgcn_mfma_f32_32x32x16_bf16(kf[5],qr[2],C1,0,0,0),   P1[6],P1[7],P1[8],P1[9],     pw2[2]=PKW(P1,4), pw2[3]=PKW(P1,6), pw2); \
    VRD(3); SBAR(); GAPA(C0=__builtin_amdgcn_mfma_f32_32x32x16_bf16(kf[6],qr[3],C0,0,0,0),   P1[10],P1[11],P1[12],P1[13], pw3[0]=PKW(P1,8), pw3[1]=PKW(P1,10), pw3); \
    VRD(7); SBAR(); GAPA(C1=__builtin_amdgcn_mfma_f32_32x32x16_bf16(kf[7],qr[3],C1,0,0,0),   P1[14],P1[15],0.f,0.f,       pw3[2]=PKW(P1,12),pw3[3]=PKW(P1,14), pw3); \
    l_reg+=sacc; \
    if(GK){DMA_K((t)+3,sl_cur);} if(GV){DMA_V((t)+1,sl_next);} \
    CMASK(C0,C1,t); \
    { float a=MX3(C0[0],C0[1],C1[0]),b=MX3(C0[2],C0[3],C1[1]); a=MX3(a,C1[2],C1[3]); \
      _Pragma("unroll") for(int r=4;r<16;r+=4){a=MX3(a,C0[r],C0[r+1]);b=MX3(b,C0[r+2],C0[r+3]);a=MX3(a,C1[r],C1[r+1]);b=MX3(b,C1[r+2],C1[r+3]);} \
      float rm=__builtin_fmaxf(a,b); { auto rr=__builtin_amdgcn_permlane32_swap(__float_as_uint(rm),__float_as_uint(rm),false,false); rm=__builtin_fmaxf(__uint_as_float(rr[0]),__uint_as_float(rr[1])); } \
      resc=false; \
      if(__builtin_expect(__any(rm>(float)THRL),0)){ const float dl=__builtin_fmaxf(rm,0.f); mhat+=dl; \
        _Pragma("unroll") for(int r=0;r<16;++r){C0[r]-=dl;C1[r]-=dl;} \
        const float f=__builtin_amdgcn_exp2f(-dl); l_reg*=f; if(hi==0)wsf[r32]=f; resc=true; } } \
    SBAR(); \
    GAPB(o[0]=__builtin_amdgcn_mfma_f32_32x32x16_bf16(PAF(0),VFR(0),o[0],0,0,0), C0,0); \
    GAPB(o[1]=__builtin_amdgcn_mfma_f32_32x32x16_bf16(PAF(0),VFR(4),o[1],0,0,0), C0,4); \
    KRD(GL,0); GAPB(o[0]=__builtin_amdgcn_mfma_f32_32x32x16_bf16(PAF(1),VFR(1),o[0],0,0,0), C0,8); \
    KRD(GL,1); GAPB(o[1]=__builtin_amdgcn_mfma_f32_32x32x16_bf16(PAF(1),VFR(5),o[1],0,0,0), C0,12); \
    KRD(GL,2); GAPB(o[0]=__builtin_amdgcn_mfma_f32_32x32x16_bf16(PAF(2),VFR(2),o[0],0,0,0), C1,0); \
    KRD(GL,3); GAPB(o[1]=__builtin_amdgcn_mfma_f32_32x32x16_bf16(PAF(2),VFR(6),o[1],0,0,0), C1,4); \
    GAPB(o[0]=__builtin_amdgcn_mfma_f32_32x32x16_bf16(PAF(3),VFR(3),o[0],0,0,0), C1,8); \
    GAPB(o[1]=__builtin_amdgcn_mfma_f32_32x32x16_bf16(PAF(3),VFR(7),o[1],0,0,0), C1,12); \
    }while(0)
  int t=1;
  for(;t+5<NT;t+=2){
    STEP(pB0,pB1,pA0,pA1,t,true,true,true);     WAIT_BAR(2); RESC(); ROT();
    STEP(pA0,pA1,pB0,pB1,t+1,true,true,true);   WAIT_BAR(2); RESC(); ROT();
  }
  #define ENDW(tt) do{ if((tt)+3<NT){WAIT_BAR(2);} else if((tt)+2<NT){WAIT_BAR(1);} else {WAIT_BAR(0);} }while(0)
  for(;t+1<NT;t+=2){
    STEP(pB0,pB1,pA0,pA1,t,(t+3<NT),(t+1<NT),(t+1<NT));       ENDW(t);   RESC(); ROT();
    STEP(pA0,pA1,pB0,pB1,t+1,(t+4<NT),(t+2<NT),(t+2<NT));     ENDW(t+1); RESC(); ROT();
  }
  STEP(pB0,pB1,pA0,pA1,NT-1,false,false,false); RESC();
  { float sacc=pB0[0]+pB0[1]; _Pragma("unroll") for(int r=2;r<16;++r)sacc+=pB0[r]; _Pragma("unroll") for(int r=0;r<16;++r)sacc+=pB1[r]; l_reg+=sacc;
    pw0=(u32x4){PKW(pB0,0),PKW(pB0,2),PKW(pB0,4),PKW(pB0,6)};pw1=(u32x4){PKW(pB0,8),PKW(pB0,10),PKW(pB0,12),PKW(pB0,14)};pw2=(u32x4){PKW(pB1,0),PKW(pB1,2),PKW(pB1,4),PKW(pB1,6)};pw3=(u32x4){PKW(pB1,8),PKW(pB1,10),PKW(pB1,12),PKW(pB1,14)};
    SBAR(); pv(o,vb0+sl_cur,PAF(0),PAF(1),PAF(2),PAF(3)); }
  #undef PKW
  #undef PAF
  #undef VFR
  #undef PIN
  #undef MX3
  #undef GAPA
  #undef GAPB
  #undef EX
  #undef VRD
  #undef KRD
  #undef STEP
  #undef ENDW
  {auto rr=__builtin_amdgcn_permlane32_swap(__float_as_uint(l_reg),__float_as_uint(l_reg),false,false);l_reg=__uint_as_float(rr[0])+__uint_as_float(rr[1]);}
  if(hi==0)wsf[32+r32]=l_reg;asm volatile("s_waitcnt lgkmcnt(0)":::"memory");
  #pragma unroll
  for(int r=0;r<16;++r){const float rl=__builtin_amdgcn_rcpf(wsf[32+crow(r,hi)]); o[0][r]*=rl; o[1][r]*=rl;}
  unsigned*stB=(unsigned*)(shm+LDS_OST)+wid*1024+lane;
  unsigned*stA=(unsigned*)(shm+LDS_STA)+wid*1024+lane;
  if(sub==0||sub==2){
    #pragma unroll
    for(int r=0;r<16;++r)stB[r*64]=cvtpk_s(o[0][r],o[1][r]);
  } else {
    f32x16 d0v,d1v;
    #pragma unroll
    for(int r=0;r<16;++r){const unsigned w=stB[r*64]; d0v[r]=__builtin_bit_cast(float,w<<16)-lam*o[0][r]; d1v[r]=__builtin_bit_cast(float,w&0xffff0000u)-lam*o[1][r];}
    if(sub==1){
      #pragma unroll
      for(int r=0;r<16;++r)stA[r*64]=cvtpk_s(d0v[r],d1v[r]);
    } else {
      f32x16 a0v,a1v; float rs[16];
      #pragma unroll
      for(int r=0;r<16;++r){const unsigned w=stA[r*64]; a0v[r]=__builtin_bit_cast(float,w<<16); a1v[r]=__builtin_bit_cast(float,w&0xffff0000u);
        rs[r]=(a0v[r]*a0v[r]+a1v[r]*a1v[r])+(d0v[r]*d0v[r]+d1v[r]*d1v[r]);}
      #pragma unroll
      for(int r=0;r<16;++r)rs[r]=__builtin_amdgcn_rsqf(half_sum(rs[r])*(1.f/128.f)+1e-5f)*0.8f;
      const float gA0=subg[r32],gA1=subg[32+r32],gB0=subg[64+r32],gB1=subg[96+r32];
      unsigned short*Ow=MIX+(rowbase+q0+wid*QBLK)*OPITCH+512+h*128;
      unsigned short*stg=(unsigned short*)(shm+LDS_OST)+wid*2048;
      asm volatile("s_waitcnt lgkmcnt(0)":::"memory");
      #pragma unroll
      for(int half=0;half<2;++half){
        #pragma unroll
        for(int r=0;r<16;++r){const int orow=crow(r,hi);
          const float v0=(half?d0v[r]:a0v[r])*rs[r]*(half?gB0:gA0), v1=(half?d1v[r]:a1v[r])*rs[r]*(half?gB1:gA1);
          stg[orow*64+r32]=(unsigned short)(cvtpk_s(v0,0.f)&0xffffu); stg[orow*64+32+r32]=(unsigned short)(cvtpk_s(v1,0.f)&0xffffu);}
        asm volatile("s_waitcnt lgkmcnt(0)":::"memory");
        #pragma unroll
        for(int i=0;i<4;++i){const int row=i*8+(lane>>3),ch=lane&7; const u32x4 v=*(const u32x4*)(stg+row*64+ch*8); *(u32x4*)(Ow+(long)row*OPITCH+half*64+ch*8)=v;}
        asm volatile("s_waitcnt lgkmcnt(0)":::"memory");
      }
    }
  }
  asm volatile("s_waitcnt lgkmcnt(0)\n\ts_barrier":::"memory");
  #undef DMA_K
  #undef DMA_V
  #undef CMASK
  #undef RESC
  #undef ROT
}
#undef SBAR
#undef WAIT_BAR
}

namespace dec {
typedef float f32x4 __attribute__((ext_vector_type(4)));
constexpr int PAST = 8192, PAGE = 128, NPG = 64, MP = 16384;
constexpr int PART_FLOATS = 16 * 128 + 32;
constexpr int LDS_MRG_BYTES = 4 * (32 * 64 * 4 + 256);
__device__ __forceinline__ float xrow16_max(float x) {
    auto s = __builtin_amdgcn_permlane16_swap(__float_as_uint(x), __float_as_uint(x), false, false);
    x = fmaxf(__uint_as_float(s[0]), __uint_as_float(s[1]));
    auto t = __builtin_amdgcn_permlane32_swap(__float_as_uint(x), __float_as_uint(x), false, false);
    return fmaxf(__uint_as_float(t[0]), __uint_as_float(t[1]));
}
__device__ __forceinline__ float xrow16_sum(float x) {
    auto s = __builtin_amdgcn_permlane16_swap(__float_as_uint(x), __float_as_uint(x), false, false);
    x = __uint_as_float(s[0]) + __uint_as_float(s[1]);
    auto t = __builtin_amdgcn_permlane32_swap(__float_as_uint(x), __float_as_uint(x), false, false);
    return __uint_as_float(t[0]) + __uint_as_float(t[1]);
}
struct KV { f32x4 k[8]; f32x4 v[4][2]; };
__device__ __forceinline__ void load_kv(KV& d, const float* kb, const float* vb) {
#pragma unroll
    for (int t = 0; t < 8; ++t) d.k[t] = __builtin_nontemporal_load((const f32x4*)(kb + 16 * t));
#pragma unroll
    for (int j = 0; j < 4; ++j)
#pragma unroll
        for (int hf = 0; hf < 2; ++hf) d.v[j][hf] = __builtin_nontemporal_load((const f32x4*)(vb + j * 512 + hf * 64));
}
__device__ __forceinline__ void dec_item(int bd, int p0, int np, const unsigned short* PQ, const float* ck, const float* cv, const int* pt, float* part, char* shm) {
    int tid_ = threadIdx.x; asm volatile("" : "+v"(tid_));
    const int tid = tid_, lane = tid & 63, n = lane & 15, kq = lane >> 4; const int wid = __builtin_amdgcn_readfirstlane(tid >> 6);
    const int h = wid & 3, half = wid >> 2;
    const float s2 = __builtin_amdgcn_exp2f(-2.f * (float)(h + 1)) * 1.4426950408889634f;
    unsigned qpk[8][2];
    { const unsigned short* qrow = PQ + (size_t)(MP + bd * 8 + (n & 7)) * 512 + h * 128 + 4 * kq;
#pragma unroll
      for (int t = 0; t < 8; ++t) { const uint2 w = *(const uint2*)(qrow + 16 * t); const bool on = ((t >> 2) == (n >> 3)); qpk[t][0] = on ? w.x : 0u; qpk[t][1] = on ? w.y : 0u; } }
#define QR(t, r) __builtin_bit_cast(float, ((r) & 1) ? (qpk[t][(r) >> 1] & 0xffff0000u) : (qpk[t][(r) >> 1] << 16))
    f32x4 O[8];
#pragma unroll
    for (int i = 0; i < 8; ++i) O[i] = (f32x4){0.f, 0.f, 0.f, 0.f};
    float m_run = -INFINITY, l_run = 0.f;
    const int NS = np * 4;
    const size_t koff = ((size_t)(half * 64 + n) * 4 + h) * 128 + 4 * kq;
    const size_t voff = ((size_t)(half * 64 + 4 * kq) * 4 + h) * 128 + 4 * n;
    const float sbl = s2 * (float)(half * 64 + 4 * kq - PAST - (n & 7));
    const int ptv = (lane < np) ? pt[bd * NPG + p0 + lane] : 0;
#define DEC_BASES(i_, KB_, VB_) const int pg_##i_ = __builtin_amdgcn_readlane(ptv, (i_) >> 2); \
    const float* KB_ = ck + (size_t)pg_##i_ * (PAGE * 512) + (size_t)((i_) & 3) * (16 * 512) + koff; const float* VB_ = cv + (size_t)pg_##i_ * (PAGE * 512) + (size_t)((i_) & 3) * (16 * 512) + voff
#define DEC_STEP(B_, i_) do { \
        f32x4 a0 = (f32x4){0.f, 0.f, 0.f, 0.f}, a1 = (f32x4){0.f, 0.f, 0.f, 0.f}; \
        _Pragma("unroll") for (int t = 0; t < 8; t += 2) _Pragma("unroll") for (int r = 0; r < 4; ++r) { \
            a0 = __builtin_amdgcn_mfma_f32_16x16x4f32(B_.k[t][r], QR(t, r), a0, 0, 0, 0); a1 = __builtin_amdgcn_mfma_f32_16x16x4f32(B_.k[t + 1][r], QR(t + 1, r), a1, 0, 0, 0); } \
        const float sb = sbl + s2 * (float)((p0 + ((i_) >> 2)) * PAGE + ((i_) & 3) * 16); \
        float sv[4]; _Pragma("unroll") for (int v = 0; v < 4; ++v) sv[v] = (a0[v] + a1[v]) + (sb + s2 * (float)v); \
        float mx = fmaxf(fmaxf(sv[0], sv[1]), fmaxf(sv[2], sv[3])); mx = xrow16_max(mx); \
        const float mn = fmaxf(m_run, mx), alpha = __builtin_amdgcn_exp2f(m_run - mn); m_run = mn; \
        float p[4]; _Pragma("unroll") for (int v = 0; v < 4; ++v) p[v] = __builtin_amdgcn_exp2f(sv[v] - mn); \
        l_run = l_run * alpha + ((p[0] + p[1]) + (p[2] + p[3])); \
        float ao[4]; _Pragma("unroll") for (int v = 0; v < 4; ++v) ao[v] = __shfl(alpha, 4 * kq + v); \
        _Pragma("unroll") for (int i = 0; i < 8; ++i) _Pragma("unroll") for (int v = 0; v < 4; ++v) O[i][v] *= ao[v]; \
        _Pragma("unroll") for (int j = 0; j < 4; ++j) _Pragma("unroll") for (int hf = 0; hf < 2; ++hf) _Pragma("unroll") for (int r = 0; r < 4; ++r) \
            O[hf * 4 + r] = __builtin_amdgcn_mfma_f32_16x16x4f32(p[j], B_.v[j][hf][r], O[hf * 4 + r], 0, 0, 0); \
    } while (0)
    KV A, B;
    { DEC_BASES(0, kb0, vb0); load_kv(A, kb0, vb0); }
    __builtin_amdgcn_sched_barrier(0);
    for (int i = 0; i < NS; i += 2) {
        { const int i1 = i + 1; DEC_BASES(i1, kb1, vb1); load_kv(B, kb1, vb1); }
        __builtin_amdgcn_sched_barrier(0);
        DEC_STEP(A, i);
        __builtin_amdgcn_sched_barrier(0);
        if (i + 2 < NS) { const int i2 = i + 2; DEC_BASES(i2, kb2, vb2); load_kv(A, kb2, vb2); }
        __builtin_amdgcn_sched_barrier(0);
        DEC_STEP(B, (i + 1));
        __builtin_amdgcn_sched_barrier(0);
    }
#undef DEC_BASES
#undef DEC_STEP
#undef QR
    l_run = xrow16_sum(l_run);
    float* mo = (float*)(shm + h * (32 * 64 * 4 + 256)); float* mml = mo + 32 * 64;
    if (half == 1) {
#pragma unroll
        for (int i = 0; i < 8; ++i)
#pragma unroll
            for (int v = 0; v < 4; ++v) mo[(i * 4 + v) * 64 + lane] = O[i][v];
        if (lane < 16) { mml[lane] = m_run; mml[16 + lane] = l_run; }
    }
    asm volatile("s_waitcnt lgkmcnt(0)" ::: "memory"); __builtin_amdgcn_s_barrier(); asm volatile("" ::: "memory");
    if (half == 0) {
        const float m1 = mml[n], l1 = mml[16 + n];
        const float M = fmaxf(m_run, m1), w0 = __builtin_amdgcn_exp2f(m_run - M), w1 = __builtin_amdgcn_exp2f(m1 - M);
        const float L = w0 * l_run + w1 * l1;
        float* rec = part + (size_t)h * PART_FLOATS;
        if (lane < 16) { rec[2048 + lane] = M; rec[2064 + lane] = L; }
#pragma unroll
        for (int v = 0; v < 4; ++v) { const float a = __shfl(w0, 4 * kq + v), b = __shfl(w1, 4 * kq + v);
#pragma unroll
            for (int hf = 0; hf < 2; ++hf) { f32x4 o;
#pragma unroll
                for (int r = 0; r < 4; ++r) o[r] = a * O[hf * 4 + r][v] + b * mo[((hf * 4 + r) * 4 + v) * 64 + lane];
                *(f32x4*)(rec + (4 * kq + v) * 128 + hf * 64 + 4 * n) = o; } }
    }
    asm volatile("s_waitcnt lgkmcnt(0)" ::: "memory"); __builtin_amdgcn_s_barrier(); asm volatile("" ::: "memory");
}
__device__ __forceinline__ float wsum(float v) {
#pragma unroll
    for (int o = 1; o < 64; o <<= 1) v += __shfl_xor(v, o);
    return v;
}
__device__ __forceinline__ void dec_combine(int rs, int h, int npart, const float* part_seq  ,
                                            const unsigned short* PQ, const unsigned short* PK, const unsigned short* PV, float lam, const float* subg, unsigned short* MIX, int lane) {
    const int bd = rs >> 3, qi = rs & 7;
    const float s2 = __builtin_amdgcn_exp2f(-2.f * (float)(h + 1)) * 1.4426950408889634f;
    float oc[2][2];
#pragma unroll
    for (int c = 0; c < 2; ++c) {
        const int row = c * 8 + qi;
        const float q = __builtin_bit_cast(float, (unsigned)PQ[(size_t)(MP + rs) * 512 + h * 128 + c * 64 + lane] << 16);
        float sn[8]; float M = -INFINITY;
#pragma unroll
        for (int tn = 0; tn < 8; ++tn) { sn[tn] = -INFINITY;
            if (tn <= qi) { const float k = __builtin_bit_cast(float, (unsigned)PK[(size_t)(MP + bd * 8 + tn) * 512 + h * 128 + c * 64 + lane] << 16);
                sn[tn] = wsum(q * k) - s2 * (float)(qi - tn); M = fmaxf(M, sn[tn]); } }
        for (int i = 0; i < npart; ++i) M = fmaxf(M, part_seq[((size_t)i * 4 + h) * PART_FLOATS + 2048 + row]);
        float L = 0.f, ox = 0.f, oy = 0.f;
        for (int i = 0; i < npart; ++i) { const float* rec = part_seq + ((size_t)i * 4 + h) * PART_FLOATS;
            const float w = __builtin_amdgcn_exp2f(rec[2048 + row] - M); const float2 ov = *(const float2*)(rec + row * 128 + 2 * lane);
            L += w * rec[2064 + row]; ox += w * ov.x; oy += w * ov.y; }
#pragma unroll
        for (int tn = 0; tn < 8; ++tn) if (tn <= qi) { const float p = __builtin_amdgcn_exp2f(sn[tn] - M);
            const unsigned w = *(const unsigned*)(PV + (size_t)(MP + bd * 8 + tn) * 512 + h * 128 + 2 * lane);
            L += p; ox += p * __builtin_bit_cast(float, w << 16); oy += p * __builtin_bit_cast(float, w & 0xffff0000u); }
        oc[c][0] = ox / L; oc[c][1] = oy / L;
    }
    const float dx = oc[0][0] - lam * oc[1][0], dy = oc[0][1] - lam * oc[1][1];
    const float rr = (1.f / sqrtf(wsum(dx * dx + dy * dy) * (1.f / 128.f) + 1e-5f)) * 0.8f;
    const float vx = dx * rr * subg[2 * lane], vy = dy * rr * subg[2 * lane + 1];
    unsigned ux = __builtin_bit_cast(unsigned, vx), uy = __builtin_bit_cast(unsigned, vy);
    ux = (ux + 0x7fffu + ((ux >> 16) & 1u)) >> 16; uy = (uy + 0x7fffu + ((uy >> 16) & 1u)) >> 16;
    *(unsigned*)(MIX + (size_t)(MP + rs) * 1024 + 512 + h * 128 + 2 * lane) = ux | (uy << 16);
}
}

namespace sk {
typedef float f32x16 __attribute__((ext_vector_type(16)));
typedef short bf16x8 __attribute__((ext_vector_type(8)));
__device__ __forceinline__ int crow(int r, int hi) { return (r & 3) + 8 * (r >> 2) + 4 * hi; }
__device__ __forceinline__ float half_sum(float v) {
#pragma unroll
    for (int o = 1; o < 32; o <<= 1) v += __shfl_xor(v, o);
    return v;
}
__device__ __forceinline__ unsigned short bf(float f) { unsigned u = __builtin_bit_cast(unsigned, f); return (unsigned short)((u + 0x7fffu + ((u >> 16) & 1u)) >> 16); }
template <int KSPLIT, class Epi>
__device__ __forceinline__ void sk_gemm(const unsigned short* A, const unsigned short* Bt, int N, int K, const Epi& E, char* shm, int vcu, int G) {
    int tid_ = threadIdx.x; asm volatile("" : "+v"(tid_));
    const int lane = tid_ & 63, r32 = lane & 31, hi = lane >> 5; const int wid = __builtin_amdgcn_readfirstlane(tid_ >> 6);
    constexpr int TPW = 8 / KSPLIT;
    const int nslot = (8 * (N / 32)) / TPW, KW = K / KSPLIT, nk = KW / 16;
    float* part = (float*)shm;
    for (int slot = vcu; slot < nslot; slot += G) {
        const int tile = slot * TPW + wid / KSPLIT, ks = wid % KSPLIT, tm = tile & 7, tn = tile >> 3;
        const unsigned short* ap = A + (size_t)(tm * 32 + r32) * K + ks * KW + 8 * hi;
        const unsigned short* bp = Bt + (size_t)(tn * 32 + r32) * K + ks * KW + 8 * hi;
        f32x16 acc = {};
        for (int s = 0; s < nk; s += 8) {
            bf16x8 a[8], b[8];
#pragma unroll
            for (int j = 0; j < 8; ++j) { a[j] = *(const bf16x8*)(ap + (s + j) * 16); b[j] = *(const bf16x8*)(bp + (s + j) * 16); }
#pragma unroll
            for (int j = 0; j < 8; ++j) acc = __builtin_amdgcn_mfma_f32_32x32x16_bf16(a[j], b[j], acc, 0, 0, 0);
        }
        if (ks != 0) {
#pragma unroll
            for (int r = 0; r < 16; ++r) part[(wid * 16 + r) * 64 + lane] = acc[r];
        }
        asm volatile("s_waitcnt lgkmcnt(0)" ::: "memory"); __builtin_amdgcn_s_barrier(); asm volatile("" ::: "memory");
        if (ks == 0) {
#pragma unroll
            for (int j = 1; j < KSPLIT; ++j)
#pragma unroll
                for (int r = 0; r < 16; ++r) acc[r] += part[((wid + j) * 16 + r) * 64 + lane];
            E(acc, tm, tn, r32, hi);
        }
        asm volatile("s_waitcnt lgkmcnt(0)" ::: "memory"); __builtin_amdgcn_s_barrier(); asm volatile("" ::: "memory");
    }
}
struct EpiIn {
    unsigned short* planes; size_t plane_elems; int row0; float* oks; float* ovs; float qscale;
    __device__ __forceinline__ void operator()(const f32x16& acc, int tm, int tn, int r32, int hi) const {
        const int col = tn * 32 + r32, t = col >> 9, pc = col & 511; const float sc = (t == 3) ? qscale : 1.f;
        unsigned short* pb = planes + (size_t)t * plane_elems + (size_t)row0 * 512 + pc;
        float* ob = (t == 4) ? oks : (t == 5) ? ovs : nullptr;
#pragma unroll
        for (int r = 0; r < 16; ++r) { const int rs = tm * 32 + crow(r, hi); pb[(size_t)rs * 512] = bf(acc[r] * sc); if (ob) ob[(size_t)rs * 512 + pc] = acc[r]; }
    }
};
template <bool WRITE_BF> struct EpiRes {
    const float* base; float* out; unsigned short* outb; float* ssq;
    __device__ __forceinline__ void operator()(const f32x16& acc, int tm, int tn, int r32, int hi) const {
        const int col = tn * 32 + r32;
#pragma unroll
        for (int r = 0; r < 16; ++r) { const int rs = tm * 32 + crow(r, hi); const size_t o = (size_t)rs * 1024 + col; const float v = base[o] + acc[r];
            out[o] = v; if (WRITE_BF) outb[o] = bf(v);
            const float s = half_sum(v * v); if (r32 == 0) ssq[rs * 32 + tn] = s; }
    }
};
struct EpiUp {
    unsigned short* O; const float* ssq; float eps;
    __device__ __forceinline__ void operator()(const f32x16& acc, int tm, int tn, int r32, int hi) const {
        const int col = tn * 32 + r32;
#pragma unroll
        for (int r = 0; r < 16; ++r) { const int rs = tm * 32 + crow(r, hi); const float tot = half_sum(ssq[rs * 32 + r32]);
            const float rstd = 1.0f / sqrtf(tot * (1.0f / 1024.0f) + eps); float v = fmaxf(acc[r] * rstd, 0.f); v *= v;
            O[(size_t)rs * 4096 + col] = bf(v); }
    }
};
}


constexpr int NWAVES = 8;
constexpr int D = 1024, SEQ = 2048, BATCH = 8, MP = BATCH * SEQ, DEC_B = 32, DEC_S = 8, MS = DEC_B * DEC_S, MT = MP + MS;
constexpr int DIN = 3072, FF = 4096, PAST = 8192, PAGE = 128, NPAGES = PAST / PAGE;
constexpr float EPS = 1e-5f, LOG2E = 1.4426950408889634f, QSCALE = 0.125f * LOG2E;
constexpr size_t O_Y = 0, O_KP = (size_t)MT * D, O_VP = O_KP + (size_t)MP * 512, O_CP = O_VP + (size_t)MP * 512,
                 O_KS = O_CP + 8 * 2 * 512, O_VS = O_KS + (size_t)MS * 512, O_CS = O_VS + (size_t)MS * 512, O_END = O_CS + 32 * 2 * 512;
static_assert(O_END == 34119680, "out size");
constexpr size_t MiB = 1u << 20;
constexpr size_t WS_CTL = 0, CTL_ZERO_BYTES = 1 * MiB;
constexpr size_t WS_WIN = 2 * MiB, WS_WO = 8 * MiB, WS_W1 = 10 * MiB, WS_W2 = 18 * MiB;
constexpr size_t WS_SSQ1 = 26 * MiB, WS_SSQ2 = 28 * MiB, WS_SSQS1 = 27 * MiB + 512 * 1024, WS_SSQS2 = 29 * MiB + 512 * 1024;
constexpr size_t WS_XN = 32 * MiB;
constexpr size_t PLANE_ELEMS = (size_t)MT * 512, WS_PL = 65 * MiB;
constexpr size_t WS_MIX = 163 * MiB, WS_X1 = 196 * MiB, WS_X1B = 261 * MiB, WS_HB = 294 * MiB, WS_PART = 424 * MiB, WS_END = 434 * MiB;
static_assert(WS_PL + 6 * PLANE_ELEMS * 2 <= WS_MIX && WS_XN + (size_t)MT * D * 2 <= WS_PL && WS_MIX + (size_t)MT * D * 2 <= WS_X1 && WS_X1 + (size_t)MT * D * 4 <= WS_X1B
              && WS_X1B + (size_t)MT * D * 2 <= WS_HB && WS_HB + (size_t)MT * FF * 2 <= WS_PART && WS_PART + (size_t)256 * 4 * dec::PART_FLOATS * 4 <= WS_END && WS_SSQ1 + (size_t)MT * 64 <= WS_SSQ2 && WS_SSQ2 + (size_t)MT * 64 <= WS_XN, "d_ws map");
constexpr int CW_BAR = 4096;
constexpr int RING_OFF = 0, RING_BYTES = 131072, LDSCTL_OFF = RING_BYTES, MISC_OFF = LDSCTL_OFF + 320, LDS_BYTES = 147456;

__device__ __forceinline__ float bflo(unsigned w) { return __builtin_bit_cast(float, w << 16); }
__device__ __forceinline__ float bfhi(unsigned w) { return __builtin_bit_cast(float, w & 0xffff0000u); }
__device__ __forceinline__ float wave_sum(float v) {
#pragma unroll
    for (int o = 1; o < 64; o <<= 1) v += __shfl_xor(v, o);
    return v;
}
__device__ __forceinline__ float wave_max(float v) {
#pragma unroll
    for (int o = 1; o < 64; o <<= 1) v = fmaxf(v, __shfl_xor(v, o));
    return v;
}

__device__ __forceinline__ void p0_transpose_item(const float* W, int K, int N, bf16* WT, const float* gk, LAS float* scr, int item, int lane) {
    const int nblk = N / 32, kb = item / nblk, nb = item % nblk, k0 = 64 * kb, n0 = 32 * nb;
#pragma unroll 8
    for (int i = 0; i < 32; ++i) { const int kk = 2 * i + (lane >> 5); float w = W[(size_t)(k0 + kk) * N + n0 + (lane & 31)]; if (gk) w *= gk[k0 + kk]; scr[kk * 33 + (lane & 31)] = w; }
    LDS_WAIT(); asm volatile("" ::: "memory");
    const int c = lane & 7;
#pragma unroll
    for (int j = 0; j < 4; ++j) { const int n = (lane >> 3) + 8 * j; const LAS float* s = scr + (8 * c) * 33 + n;
        v4u o; o.x = pk2(s[0 * 33], s[1 * 33]); o.y = pk2(s[2 * 33], s[3 * 33]); o.z = pk2(s[4 * 33], s[5 * 33]); o.w = pk2(s[6 * 33], s[7 * 33]);
        *(GAS v4u*)(WT + (size_t)(n0 + n) * K + k0 + 8 * c) = o; }
    LDS_WAIT(); asm volatile("" ::: "memory");
}
__device__ __forceinline__ void rms_row_to_bf16(const float* xrow, const float* g, bf16* orow, int lane) {
    const GAS f32x4* xr = (const GAS f32x4*)xrow + lane; const GAS f32x4* gr = (const GAS f32x4*)g + lane;
    f32x4 v[4]; float s = 0.f;
#pragma unroll
    for (int j = 0; j < 4; ++j) { v[j] = xr[64 * j]; s += (v[j].x * v[j].x + v[j].y * v[j].y) + (v[j].z * v[j].z + v[j].w * v[j].w); }
    const float rstd = 1.f / sqrtf(wave_sum(s) * (1.f / D) + EPS);
    GAS unsigned long long* o8 = (GAS unsigned long long*)orow + lane;
#pragma unroll
    for (int j = 0; j < 4; ++j) { const f32x4 gg = gr[64 * j];
        o8[64 * j] = (unsigned long long)pk2(v[j].x * rstd * gg.x, v[j].y * rstd * gg.y) | ((unsigned long long)pk2(v[j].z * rstd * gg.z, v[j].w * rstd * gg.w) << 32); }
}


#ifndef REP_P0
#define REP_P0 1
#endif
#ifndef REP_P1
#define REP_P1 1
#endif
#ifndef REP_P2
#define REP_P2 1
#endif
#ifndef REP_P2b
#define REP_P2b 1
#endif
#ifndef REP_P3
#define REP_P3 1
#endif
#ifndef REP_P4
#define REP_P4 1
#endif
#ifndef REP_P5
#define REP_P5 1
#endif
#ifndef REP_ATT
#define REP_ATT 1
#endif
#ifndef REP_DEC
#define REP_DEC 1
#endif
#define PH_BEGIN(k) for (int rep_ = 0; rep_ < REP_##k; ++rep_) {
#define PH_END }
struct Args { const void* in[19]; float* out; unsigned char* ws; };

__device__ __forceinline__ void p2_conv(const bf16* PB, const bf16* PC, const bf16* PU, const float* state, const float* cw, bf16* MIX, float* out, int gtid, int nthr) {
    for (int it = gtid; it < MT * 64; it += nthr) {
        const int r = it >> 6, ch = (it & 63) * 8;
        int t, T, seq; const float* st = nullptr; size_t ocs;
        if (r < MP) { t = r % SEQ; T = SEQ; seq = r / SEQ; ocs = O_CP; } else { const int q = r - MP; t = q % DEC_S; T = DEC_S; seq = q / DEC_S; st = state + (size_t)seq * 2 * 512; ocs = O_CS; }
        float e[3][8];
#pragma unroll
        for (int j = 0; j < 3; ++j) { const int ei = t + j;
            if (ei < 2) {
#pragma unroll
                for (int k = 0; k < 8; ++k) e[j][k] = st ? st[ei * 512 + ch + k] : 0.f;
            } else { const size_t o = (size_t)(r - 2 + j) * 512 + ch; const v4u c = *(const GAS v4u*)(PC + o), u = *(const GAS v4u*)(PU + o);
#pragma unroll
                for (int k = 0; k < 4; ++k) { e[j][2 * k] = bflo(c[k]) * bflo(u[k]); e[j][2 * k + 1] = bfhi(c[k]) * bfhi(u[k]); } } }
        const v4u b = *(const GAS v4u*)(PB + (size_t)r * 512 + ch);
        float y[8];
#pragma unroll
        for (int k = 0; k < 8; ++k) y[k] = e[0][k] * cw[ch + k] + e[1][k] * cw[512 + ch + k] + e[2][k] * cw[1024 + ch + k];
        v4u o;
#pragma unroll
        for (int k = 0; k < 4; ++k) o[k] = pk2(bflo(b[k]) * y[2 * k], bfhi(b[k]) * y[2 * k + 1]);
        *(GAS v4u*)(MIX + (size_t)r * D + ch) = o;
        if (t >= T - 2) { float* oc = out + ocs + ((size_t)seq * 2 + (t - (T - 2))) * 512 + ch;
            *(f32x4*)oc = (f32x4){e[2][0], e[2][1], e[2][2], e[2][3]}; *(f32x4*)(oc + 4) = (f32x4){e[2][4], e[2][5], e[2][6], e[2][7]}; }
    }
}
__device__ __forceinline__ void p2_attn_naive(const bf16* PQ, const bf16* PK, const bf16* PV, const float* ck, const float* cv, const int* pt, float lam, const float* subg,
                                              bf16* MIX, LAS float* qs, int gw, int ngw, int lane, int row_lo, int row_hi) {
    for (int task = gw; task < (row_hi - row_lo) * 4; task += ngw) {
        const int r = row_lo + (task >> 2), h = task & 3;
        const float slope2 = exp2f(-2.f * (h + 1)) * LOG2E;
        const bool dec = r >= MP;
        int qpos, bd = 0, rowbase;
        if (!dec) { qpos = r % SEQ; rowbase = r - qpos; } else { const int q = r - MP; bd = q / DEC_S; qpos = PAST + q % DEC_S; rowbase = MP + bd * DEC_S - PAST; }
        { const unsigned w = *(const GAS unsigned*)(PQ + (size_t)r * 512 + h * 128 + 2 * lane); qs[2 * lane] = bflo(w); qs[2 * lane + 1] = bfhi(w); }
        LDS_WAIT(); asm volatile("" ::: "memory");
        float m1 = -1e30f, m2 = -1e30f, l1 = 0.f, l2 = 0.f, a1x = 0.f, a1y = 0.f, a2x = 0.f, a2y = 0.f;
        for (int j0 = 0; j0 <= qpos; j0 += 64) {
            const int j = j0 + lane; const bool valid = j <= qpos;
            float s1 = -1e30f, s2 = -1e30f;
            if (valid) {
                float d1 = 0.f, d2 = 0.f;
                if (dec && j < PAST) { const int pg = pt[bd * NPAGES + j / PAGE]; const float* kp = ck + (((size_t)pg * PAGE + (j % PAGE)) * 4 + h) * 128;
#pragma unroll 4
                    for (int d = 0; d < 64; d += 4) { const f32x4 ka = *(const GAS f32x4*)(kp + d), kb = *(const GAS f32x4*)(kp + 64 + d);
                        d1 += qs[d] * ka.x + qs[d + 1] * ka.y + qs[d + 2] * ka.z + qs[d + 3] * ka.w;
                        d2 += qs[64 + d] * kb.x + qs[64 + d + 1] * kb.y + qs[64 + d + 2] * kb.z + qs[64 + d + 3] * kb.w; }
                } else { const bf16* kp = PK + (size_t)(rowbase + j) * 512 + h * 128;
#pragma unroll 2
                    for (int d = 0; d < 64; d += 8) { const v4u ka = *(const GAS v4u*)(kp + d), kb = *(const GAS v4u*)(kp + 64 + d);
#pragma unroll
                        for (int k = 0; k < 4; ++k) { d1 += qs[d + 2 * k] * bflo(ka[k]) + qs[d + 2 * k + 1] * bfhi(ka[k]); d2 += qs[64 + d + 2 * k] * bflo(kb[k]) + qs[64 + d + 2 * k + 1] * bfhi(kb[k]); } }
                }
                const float bias = -slope2 * (float)(qpos - j);
                s1 = d1 + bias; s2 = d2 + bias;
            }
            const float n1 = fmaxf(m1, wave_max(s1)), n2 = fmaxf(m2, wave_max(s2));
            const float f1 = exp2f(m1 - n1), f2 = exp2f(m2 - n2);
            const float p1 = valid ? exp2f(s1 - n1) : 0.f, p2 = valid ? exp2f(s2 - n2) : 0.f;
            l1 = l1 * f1 + wave_sum(p1); l2 = l2 * f2 + wave_sum(p2);
            a1x *= f1; a1y *= f1; a2x *= f2; a2y *= f2; m1 = n1; m2 = n2;
            const int jn = min(64, qpos - j0 + 1);
            for (int jj = 0; jj < jn; ++jj) {
                const int jk = j0 + jj; float vx, vy;
                if (dec && jk < PAST) { const int pg = pt[bd * NPAGES + jk / PAGE]; const float* vp = cv + (((size_t)pg * PAGE + (jk % PAGE)) * 4 + h) * 128; vx = vp[2 * lane]; vy = vp[2 * lane + 1]; }
                else { const unsigned w = *(const GAS unsigned*)(PV + (size_t)(rowbase + jk) * 512 + h * 128 + 2 * lane); vx = bflo(w); vy = bfhi(w); }
                const float q1 = __shfl(p1, jj), q2 = __shfl(p2, jj);
                a1x += q1 * vx; a1y += q1 * vy; a2x += q2 * vx; a2y += q2 * vy;
            }
        }
        const float ox = a1x / l1 - lam * (a2x / l2), oy = a1y / l1 - lam * (a2y / l2);
        const float rr = (1.f / sqrtf(wave_sum(ox * ox + oy * oy) * (1.f / 128.f) + EPS)) * 0.8f;
        *(GAS unsigned*)(MIX + (size_t)r * D + 512 + h * 128 + 2 * lane) = pk2(ox * rr * subg[2 * lane], oy * rr * subg[2 * lane + 1]);
        LDS_WAIT(); asm volatile("" ::: "memory");
    }
}

__global__ void __launch_bounds__(NWAVES * 64, 2) hymba_fwd(Args args) {
    extern __shared__ __attribute__((aligned(16))) unsigned char lds_raw[];
    LAS unsigned char* lds = (LAS unsigned char*)lds_raw;
    const int tid = threadIdx.x, lane = tid & 63, wave = __builtin_amdgcn_readfirstlane(tid >> 6);
    const int G = gridDim.x, bx = blockIdx.x;
    const int vcu = (G % 8 == 0) ? (bx % 8) * (G / 8) + bx / 8 : bx;
    unsigned char* ws = args.ws; float* out = args.out;
    const float* x_p = (const float*)args.in[0]; const float* x_s = (const float*)args.in[1];
    const float* ck = (const float*)args.in[2]; const float* cv = (const float*)args.in[3]; const float* state = (const float*)args.in[4];
    const int* pt = (const int*)args.in[5];
    const float* g1 = (const float*)args.in[6]; const float* w_in = (const float*)args.in[7]; const float* cw = (const float*)args.in[8];
    const float* lq1 = (const float*)args.in[9]; const float* lk1 = (const float*)args.in[10]; const float* lq2 = (const float*)args.in[11]; const float* lk2 = (const float*)args.in[12];
    const float* subg = (const float*)args.in[13]; const float* w_out = (const float*)args.in[14]; const float* g2 = (const float*)args.in[15];
    const float* w_up = (const float*)args.in[16]; const float* w_down = (const float*)args.in[17]; const float* gf = (const float*)args.in[18];
    bf16* Win_t = (bf16*)(ws + WS_WIN); bf16* Wo_t = (bf16*)(ws + WS_WO); bf16* W1_t = (bf16*)(ws + WS_W1); bf16* W2_t = (bf16*)(ws + WS_W2);
    float* SSQ1 = (float*)(ws + WS_SSQ1); float* SSQ2 = (float*)(ws + WS_SSQ2); float* SSQS1 = (float*)(ws + WS_SSQS1); float* SSQS2 = (float*)(ws + WS_SSQS2);
    char* shm = (char*)lds_raw + RING_OFF;
    bf16* XN = (bf16*)(ws + WS_XN); bf16* PL = (bf16*)(ws + WS_PL); bf16* MIX = (bf16*)(ws + WS_MIX);
    float* X1 = (float*)(ws + WS_X1); bf16* X1B = (bf16*)(ws + WS_X1B); bf16* HB = (bf16*)(ws + WS_HB);
    unsigned* ctl = (unsigned*)(ws + WS_CTL);

    for (int u = tid; u < (LDS_BYTES - LDSCTL_OFF) / 4; u += NWAVES * 64) ((LAS unsigned*)(lds + LDSCTL_OFF))[u] = 0u;
    __syncthreads();
    XcdBarrier bar = xcd_barrier_post(ctl + CW_BAR, (volatile LAS unsigned*)(lds + MISC_OFF) + 8);
    const int gw = vcu * NWAVES + wave, NGW = G * NWAVES;

    PH_BEGIN(P0)
    {
        LAS float* scr = (LAS float*)(lds + RING_OFF + wave * 16384);
        constexpr int I_IN = (D / 64) * (DIN / 32), I_O = (D / 64) * (D / 32), I_1 = (D / 64) * (FF / 32), I_2 = (FF / 64) * (D / 32);
        constexpr int NITEMS = I_IN + I_O + I_1 + I_2;
        for (int it = gw; it < NITEMS; it += NGW) {
            int r = it;
            if (r < I_IN) { p0_transpose_item(w_in, D, DIN, Win_t, nullptr, scr, r, lane); continue; } r -= I_IN;
            if (r < I_O) { p0_transpose_item(w_out, D, D, Wo_t, nullptr, scr, r, lane); continue; } r -= I_O;
            if (r < I_1) { p0_transpose_item(w_up, D, FF, W1_t, g2, scr, r, lane); continue; } r -= I_1;
            p0_transpose_item(w_down, FF, D, W2_t, nullptr, scr, r, lane);
        }
        for (int m = gw; m < MT; m += NGW) rms_row_to_bf16(m < MP ? x_p + (size_t)m * D : x_s + (size_t)(m - MP) * D, g1, XN + (size_t)m * D, lane);
    }
    xcd_barrier(bar);
    PH_END

    PH_BEGIN(P1)
    {
        { sk::EpiIn Es{PL, PLANE_ELEMS, MP, out + O_KS, out + O_VS, QSCALE}; sk::sk_gemm<2>(XN + (size_t)MP * D, Win_t, DIN, D, Es, shm, vcu, G); }
        pg8::Gemm g{XN, Win_t, MP, DIN, D}; pg8::StaticOrder S; S.init(MP, DIN, G, bx);
        pg8::EpiInProj E{PL, PLANE_ELEMS, out + O_KP, out + O_VP, out + O_KS, out + O_VS, QSCALE};
        pg8::gemm_phase<pg8::EpiInProj, pg8::StaticOrder, true, true>(lds + RING_OFF, g, S, E);
    }
    xcd_barrier(bar);
    PH_END

    const float lam_v = exp2f(wave_sum(lq1[lane] * lk1[lane]) * LOG2E) - exp2f(wave_sum(lq2[lane] * lk2[lane]) * LOG2E) + 0.2f;
    const float lam = __builtin_bit_cast(float, __builtin_amdgcn_readfirstlane(__builtin_bit_cast(int, lam_v)));
    PH_BEGIN(P2)
    {
        p2_conv(PL, PL + PLANE_ELEMS, PL + 2 * PLANE_ELEMS, state, cw, MIX, out, bx * NWAVES * 64 + tid, G * NWAVES * 64);
        const bf16* PQ = PL + 3 * PLANE_ELEMS; const bf16* PK = PL + 4 * PLANE_ELEMS; const bf16* PV = PL + 5 * PLANE_ELEMS;
        float* PART = (float*)(ws + WS_PART);
        const bool attn_first = (vcu & 1) == 0;
        for (int slot = 0; slot < 2; ++slot) {
            if ((slot == 0) == attn_first) {
                for (int ra_ = 0; ra_ < REP_ATT; ++ra_)
                for (int u = vcu; u < 256; u += G) {
                    const int b = u >> 5, h = (u >> 3) & 3, qb = u & 7;
                    for (int sub = 0; sub < 4; ++sub)
                        dattn::attn_sub<8>(b, h, qb, sub, (const dattn::bf16*)PQ, (const dattn::bf16*)PK, (const dattn::bf16*)PV, MIX, lam, subg, (char*)lds_raw + RING_OFF);
                }
            } else {
                for (int rd_ = 0; rd_ < REP_DEC; ++rd_)
                for (int u = vcu; u < 256; u += G)
                    dec::dec_item(u >> 3, (u & 7) * 8, 8, PQ, ck, cv, pt, PART + (size_t)u * 4 * dec::PART_FLOATS, (char*)lds_raw + RING_OFF);
            }
        }
    }
    xcd_barrier(bar);
    PH_END

    PH_BEGIN(P2b)
    {
        const float* PART = (const float*)(ws + WS_PART);
        for (int task = gw; task < MS * 4; task += NGW) { const int rs = task >> 2;
            dec::dec_combine(rs, task & 3, 8, PART + (size_t)(rs >> 3) * 8 * 4 * dec::PART_FLOATS, PL + 3 * PLANE_ELEMS, PL + 4 * PLANE_ELEMS, PL + 5 * PLANE_ELEMS, lam, subg, MIX, lane); }
    }
    xcd_barrier(bar);
    PH_END

    PH_BEGIN(P3)
    {
        { sk::EpiRes<true> Es{x_s, X1 + (size_t)MP * D, X1B + (size_t)MP * D, SSQS1}; sk::sk_gemm<8>(MIX + (size_t)MP * D, Wo_t, D, D, Es, shm, vcu, G); }
        pg8::Gemm g{MIX, Wo_t, MP, D, D}; pg8::StaticOrder S; S.init(MP, D, G, bx);
        pg8::EpiResid<true> E{x_p, x_s, X1, X1B, SSQ1};
        pg8::gemm_phase<pg8::EpiResid<true>, pg8::StaticOrder, true, true>(lds + RING_OFF, g, S, E);
    }
    xcd_barrier(bar);
    PH_END

    PH_BEGIN(P4)
    {
        { sk::EpiUp Es{HB + (size_t)MP * FF, SSQS1, EPS}; sk::sk_gemm<2>(X1B + (size_t)MP * D, W1_t, FF, D, Es, shm, vcu, G); }
        pg8::Gemm g{X1B, W1_t, MP, FF, D}; pg8::StaticOrder S; S.init(MP, FF, G, bx);
        pg8::EpiUp E{HB, FF, SSQ1, EPS};
        pg8::gemm_phase<pg8::EpiUp, pg8::StaticOrder, true, true>(lds + RING_OFF, g, S, E);
    }
    xcd_barrier(bar);
    PH_END

    PH_BEGIN(P5)
    {
        { sk::EpiRes<false> Es{X1 + (size_t)MP * D, out + O_Y + (size_t)MP * D, nullptr, SSQS2}; sk::sk_gemm<8>(HB + (size_t)MP * FF, W2_t, D, FF, Es, shm, vcu, G); }
        pg8::Gemm g{HB, W2_t, MP, D, FF}; pg8::StaticOrder S; S.init(MP, D, G, bx);
        pg8::EpiResid<false> E{X1, X1 + (size_t)MP * D, out + O_Y, nullptr, SSQ2};
        pg8::gemm_phase<pg8::EpiResid<false>, pg8::StaticOrder, true, true>(lds + RING_OFF, g, S, E);
    }
    xcd_barrier(bar);
    PH_END

    for (int m = gw; m < MT; m += NGW) {
        GAS f32x4* yr = (GAS f32x4*)(out + O_Y + (size_t)m * D) + lane; const GAS f32x4* gr = (const GAS f32x4*)gf + lane;
        const float sp = (m < MP) ? ((lane < 16) ? SSQ2[(size_t)m * 16 + lane] : 0.f) : ((lane < 32) ? SSQS2[(size_t)(m - MP) * 32 + lane] : 0.f);
        float tot = sp; tot += __shfl_xor(tot, 1); tot += __shfl_xor(tot, 2); tot += __shfl_xor(tot, 4); tot += __shfl_xor(tot, 8); tot += __shfl_xor(tot, 16);
        tot = __shfl(tot, 0);
        const float rstd = 1.f / sqrtf(tot * (1.f / D) + EPS);
#pragma unroll
        for (int j = 0; j < 4; ++j) { const f32x4 v = yr[64 * j], gg = gr[64 * j]; yr[64 * j] = (f32x4){v.x * rstd * gg.x, v.y * rstd * gg.y, v.z * rstd * gg.z, v.w * rstd * gg.w}; }
    }
}

extern "C" void kernel_launch(void* const* d_in, const int* in_sizes, int n_in, void* d_out, int out_size, void* d_ws, size_t ws_size, hipStream_t stream) {
    static int grid = 0;
    if (grid == 0) {
        if (n_in != 19 || out_size != (int)O_END || ws_size < WS_END) { fprintf(stderr, "kernel_launch: unexpected shapes (n_in %d out %d ws %zu)\n", n_in, out_size, ws_size); grid = -1; return; }
        int dev = 0, cus = 0, per_cu = 0;
        if (hipGetDevice(&dev) != hipSuccess || hipDeviceGetAttribute(&cus, hipDeviceAttributeMultiprocessorCount, dev) != hipSuccess) { grid = -1; return; }
        if (hipFuncSetAttribute((const void*)hymba_fwd, hipFuncAttributeMaxDynamicSharedMemorySize, LDS_BYTES) != hipSuccess) { fprintf(stderr, "kernel_launch: hipFuncSetAttribute failed\n"); grid = -1; return; }
        if (hipOccupancyMaxActiveBlocksPerMultiprocessor(&per_cu, (const void*)hymba_fwd, NWAVES * 64, LDS_BYTES) != hipSuccess || per_cu < 1) { fprintf(stderr, "kernel_launch: occupancy query reports %d\n", per_cu); }
        (void)hipGetLastError();
        grid = cus;
    }
    if (grid < 0) return;
    if (hipMemsetAsync((char*)d_ws + WS_CTL, 0, CTL_ZERO_BYTES, stream) != hipSuccess) return;
    Args a{};
    for (int i = 0; i < 19; ++i) a.in[i] = d_in[i];
    a.out = (float*)d_out; a.ws = (unsigned char*)d_ws;
    hipLaunchKernelGGL(hymba_fwd, dim3(grid), dim3(NWAVES * 64), LDS_BYTES, stream, a);
}
```

```cpp
#include <hip/hip_runtime.h>
#include <cstdio>
#include <cstdint>

namespace pg8 {
#define PG8_LAS __attribute__((address_space(3)))
typedef unsigned short bf16_t;
typedef short bf16x8 __attribute__((ext_vector_type(8)));
typedef float f32x4 __attribute__((ext_vector_type(4)));
typedef unsigned u32x4 __attribute__((ext_vector_type(4)));
constexpr int BM = 256, BK = 64, HALF = 128, HTB = HALF * BK * 2  , STAGE_BYTES = 8 * HTB, NXCD = 8, WGM = 8;

__host__ __device__ __forceinline__ int lds_byte(int r, int c) { const int st = (r >> 4) * 2 + (c >> 5), rr = r & 15, cc = c & 31, ob = rr * 64 + cc * 2; return st * 1024 + (ob ^ (((ob >> 9) & 1) << 5)); }
__host__ __device__ __forceinline__ void stage_rc(int b, int& R, int& C) { const int st = b / 1024, sb = b % 1024, swz = sb ^ (((sb >> 9) & 1) << 5); R = (st >> 1) * 16 + swz / 64; C = (st & 1) * 32 + (swz % 64) / 2; }
__host__ __device__ __forceinline__ int perm32(int rho) { const int n = rho >> 4, i = rho & 15; return 8 * (i >> 2) + 4 * n + (i & 3); }

struct Unit { int pm, pn; };
struct Gemm { const bf16_t* A; const bf16_t* Bt; int M, N, K; };

struct StaticOrder {
    int nM, nN, nwg, G, c;
    __host__ __device__ void init(int M, int N, int G_, int c_) { nM = M / BM; nN = N / BM; nwg = nM * nN; G = G_; c = c_; }
    __host__ __device__ bool next(int i, Unit& u) const {
        const long L = (long)i * G + c; if (L >= nwg) return false;
        int wgid = (int)L; { const int q = nwg / NXCD, r = nwg % NXCD, xcd = wgid % NXCD, off = wgid / NXCD; wgid = (xcd < r ? xcd * (q + 1) : r * (q + 1) + (xcd - r) * q) + off; }
        const int nig = WGM * nN, gid = wgid / nig, fm = gid * WGM, gsz = (nM - fm) < WGM ? (nM - fm) : WGM;
        u.pm = fm + ((wgid % nig) % gsz); u.pn = (wgid % nig) / gsz; return true;
    }
    __device__ __forceinline__ void a_ready(const Unit&) const {}
    __device__ __forceinline__ void done(const Unit&) const {}
};


__device__ __forceinline__ unsigned cvt_pk_bf16(float lo, float hi) { unsigned r; asm volatile("v_cvt_pk_bf16_f32 %0, %1, %2" : "=v"(r) : "v"(lo), "v"(hi)); return r; }
typedef float f32x2 __attribute__((ext_vector_type(2)));

typedef float f32x2 __attribute__((ext_vector_type(2)));
constexpr int ROWS_P = 16384;
struct EpiInProj {
    static constexpr bool PERM = true, AFTER_DRAIN = false;
    bf16_t* planes; size_t plane_elems; float* okp; float* ovp; float* oks; float* ovs; float qscale;
    __device__ __forceinline__ void operator()(const f32x4 (&acc)[2][2][4][2], const Unit& u, int wr, int wc, int fr, int fq) const {
        const int t = u.pn >> 1; const int colb = (u.pn & 1) * 256 + wc * 32 + 8 * fq;
        const float sc = (t == 3) ? qscale : 1.f;
        bf16_t* pb = planes + (size_t)t * plane_elems;
        float* ob = nullptr;
        if (t == 4) ob = (u.pm < ROWS_P / BM) ? okp : oks - (size_t)ROWS_P * 512;
        if (t == 5) ob = (u.pm < ROWS_P / BM) ? ovp : ovs - (size_t)ROWS_P * 512;
        const int row0 = u.pm * BM + wr * 64 + fr;
#pragma unroll
        for (int ai = 0; ai < 2; ++ai)
#pragma unroll
            for (int m = 0; m < 4; ++m) { const size_t ro = (size_t)(row0 + ai * HALF + m * 16) * 512 + colb;
#pragma unroll
                for (int bj = 0; bj < 2; ++bj) { const f32x4 v0 = acc[ai][bj][m][0], v1 = acc[ai][bj][m][1];
                    if (ob) { *(f32x4*)(ob + ro + bj * HALF) = v0; *(f32x4*)(ob + ro + bj * HALF + 4) = v1; }
                    u32x4 w; w.x = cvt_pk_bf16(v0[0] * sc, v0[1] * sc); w.y = cvt_pk_bf16(v0[2] * sc, v0[3] * sc); w.z = cvt_pk_bf16(v1[0] * sc, v1[1] * sc); w.w = cvt_pk_bf16(v1[2] * sc, v1[3] * sc);
                    *(u32x4*)(pb + ro + bj * HALF) = w; } }
    }
};
template <bool WRITE_BF> struct EpiResid {
    static constexpr bool PERM = true, AFTER_DRAIN = false;
    const float* base_p; const float* base_s;
    float* out; bf16_t* outb; float* ssq;
    __device__ __forceinline__ void operator()(const f32x4 (&acc)[2][2][4][2], const Unit& u, int wr, int wc, int fr, int fq) const {
        const int col0 = u.pn * BM + wc * 32 + 8 * fq; const int row0 = u.pm * BM + wr * 64 + fr;
        const float* bb = (u.pm < ROWS_P / BM) ? base_p : base_s - (size_t)ROWS_P * 1024;
#pragma unroll
        for (int ai = 0; ai < 2; ++ai)
#pragma unroll
            for (int m = 0; m < 4; ++m) { const int row = row0 + ai * HALF + m * 16; const size_t ro = (size_t)row * 1024 + col0; float s = 0.f;
#pragma unroll
                for (int bj = 0; bj < 2; ++bj) { const f32x4 x0 = *(const f32x4*)(bb + ro + bj * HALF), x1 = *(const f32x4*)(bb + ro + bj * HALF + 4);
                    const f32x4 v0 = acc[ai][bj][m][0] + x0, v1 = acc[ai][bj][m][1] + x1;
                    *(f32x4*)(out + ro + bj * HALF) = v0; *(f32x4*)(out + ro + bj * HALF + 4) = v1;
                    if (WRITE_BF) { u32x4 w; w.x = cvt_pk_bf16(v0[0], v0[1]); w.y = cvt_pk_bf16(v0[2], v0[3]); w.z = cvt_pk_bf16(v1[0], v1[1]); w.w = cvt_pk_bf16(v1[2], v1[3]); *(u32x4*)(outb + ro + bj * HALF) = w; }
                    s += (v0[0] * v0[0] + v0[1] * v0[1]) + (v0[2] * v0[2] + v0[3] * v0[3]) + (v1[0] * v1[0] + v1[1] * v1[1]) + (v1[2] * v1[2] + v1[3] * v1[3]); }
                s += __shfl_xor(s, 16); s += __shfl_xor(s, 32);
                if (fq == 0) ssq[(size_t)row * 16 + u.pn * 4 + wc] = s; }
    }
};
struct EpiUp {
    static constexpr bool PERM = true, AFTER_DRAIN = false;
    bf16_t* O; int ldc; const float* ssq; float eps;
    __device__ __forceinline__ void operator()(const f32x4 (&acc)[2][2][4][2], const Unit& u, int wr, int wc, int fr, int fq) const {
        const int col0 = u.pn * BM + wc * 32 + 8 * fq; const int row0 = u.pm * BM + wr * 64 + fr;
#pragma unroll
        for (int ai = 0; ai < 2; ++ai)
#pragma unroll
            for (int m = 0; m < 4; ++m) { const int row = row0 + ai * HALF + m * 16; const f32x4* sp = (const f32x4*)(ssq + (size_t)row * 16);
                const f32x4 a = sp[0], b = sp[1], c = sp[2], d = sp[3];
                const float tot = (((a[0] + a[1]) + (a[2] + a[3])) + ((b[0] + b[1]) + (b[2] + b[3]))) + (((c[0] + c[1]) + (c[2] + c[3])) + ((d[0] + d[1]) + (d[2] + d[3])));
                const float rstd = 1.0f / sqrtf(tot * (1.0f / 1024.0f) + eps);
                bf16_t* rowp = O + (size_t)row * ldc + col0;
#pragma unroll
                for (int bj = 0; bj < 2; ++bj) { f32x4 v0 = acc[ai][bj][m][0] * rstd, v1 = acc[ai][bj][m][1] * rstd;
#pragma unroll
                    for (int e = 0; e < 4; ++e) { v0[e] = fmaxf(v0[e], 0.f); v0[e] *= v0[e]; v1[e] = fmaxf(v1[e], 0.f); v1[e] *= v1[e]; }
                    u32x4 w; w.x = cvt_pk_bf16(v0[0], v0[1]); w.y = cvt_pk_bf16(v0[2], v0[3]); w.z = cvt_pk_bf16(v1[0], v1[1]); w.w = cvt_pk_bf16(v1[2], v1[3]);
                    *(u32x4*)(rowp + bj * HALF) = w; } }
    }
};

template <class Epi, class Sched, bool ALIGN_EPI = false, bool SP2 = false>
__device__ __forceinline__ void gemm_phase(PG8_LAS unsigned char* lds, const Gemm g, const Sched& S, const Epi& E) {
    int tid_ = threadIdx.x; asm volatile("" : "+v"(tid_));
    const int tid = tid_, wid = __builtin_amdgcn_readfirstlane(tid >> 6), lane = tid & 63, wr = wid >> 2, wc = wid & 3, fr = lane & 15, fq = lane >> 4;
    const int K = g.K, nt = K / BK;
    unsigned voffA[2], voffB[2];
#pragma unroll
    for (int i = 0; i < 2; ++i) { int R, C; stage_rc(tid * 16 + i * 8192, R, C); const int Rb = Epi::PERM ? ((R & ~31) + perm32(R & 31)) : R;
        voffA[i] = (unsigned)(R * K + C) * 2u; voffB[i] = (unsigned)(Rb * K + C) * 2u; }
    const size_t kstep = (size_t)(BK * 2);
    const size_t hstep = (size_t)HALF * K * 2;
    const size_t tstep = 2 * hstep;
    const unsigned ldsw = (unsigned)wid * 1024u;
    const int aoff = lds_byte(wr * 64 + fr, fq * 8), boff = lds_byte(wc * 32 + fr, fq * 8);
#define PG8_SA(b, h) (((b) * 2 + (h)) * HTB)
#define PG8_SB(b, h) ((4 + (b) * 2 + (h)) * HTB)
#define PG8_STAGE(bufoff, gbase, voff) do { _Pragma("unroll") for (int _i = 0; _i < 2; ++_i) \
        __builtin_amdgcn_global_load_lds((const unsigned*)((const char*)(gbase) + (voff)[_i]), (PG8_LAS unsigned*)(lds + (bufoff) + ldsw + _i * 8192), 16, 0, 0); } while (0)
#define PG8_LDA(dst, b, h) do { _Pragma("unroll") for (int m = 0; m < 4; ++m) _Pragma("unroll") for (int k = 0; k < 2; ++k) dst[m][k] = *(const PG8_LAS bf16x8*)(lds + PG8_SA(b, h) + aoff + m * 2048 + k * 1024); } while (0)
#define PG8_LDB(dst, b, h) do { _Pragma("unroll") for (int n = 0; n < 2; ++n) _Pragma("unroll") for (int k = 0; k < 2; ++k) dst[n][k] = *(const PG8_LAS bf16x8*)(lds + PG8_SB(b, h) + boff + n * 2048 + k * 1024); } while (0)
#define PG8_MMA(ai, bj, At, Bt) do { __builtin_amdgcn_s_setprio(1); _Pragma("unroll") for (int m = 0; m < 4; ++m) _Pragma("unroll") for (int n = 0; n < 2; ++n) _Pragma("unroll") for (int k = 0; k < 2; ++k) \
        acc[ai][bj][m][n] = __builtin_amdgcn_mfma_f32_16x16x32_bf16(Bt[n][k], At[m][k], acc[ai][bj][m][n], 0, 0, 0); __builtin_amdgcn_s_setprio(0); } while (0)
#define PG8_WAIT_V(n) asm volatile("s_waitcnt vmcnt(" #n ")" ::: "memory")
#define PG8_WAIT_L(n) asm volatile("s_waitcnt lgkmcnt(" #n ")" ::: "memory")
#define PG8_BAR __builtin_amdgcn_s_barrier()
#define PG8_SCHED __builtin_amdgcn_sched_barrier(0)
    Unit cur, nxt; int ui = 0;
    if (!S.next(0, cur)) return;
    f32x4 acc[2][2][4][2];
#pragma unroll
    for (int a = 0; a < 2; ++a)
#pragma unroll
        for (int b = 0; b < 2; ++b)
#pragma unroll
            for (int m = 0; m < 4; ++m)
#pragma unroll
                for (int n = 0; n < 2; ++n) acc[a][b][m][n] = (f32x4){0.f, 0.f, 0.f, 0.f};
    bf16x8 At[4][2], B0[2][2], B1[2][2];
    const char* cA = (const char*)g.A + (size_t)cur.pm * tstep; const char* cB = (const char*)g.Bt + (size_t)cur.pn * tstep;
    S.a_ready(cur);
    if constexpr (SP2) {
        PG8_STAGE(PG8_SB(0, 0), cB, voffB); PG8_STAGE(PG8_SB(0, 1), cB + hstep, voffB); PG8_STAGE(PG8_SA(0, 0), cA, voffA); PG8_STAGE(PG8_SA(0, 1), cA + hstep, voffA);
        if (wr == 1) PG8_BAR;
        PG8_WAIT_V(2); PG8_BAR;
        PG8_STAGE(PG8_SB(1, 0), cB + kstep, voffB); PG8_STAGE(PG8_SA(1, 0), cA + kstep, voffA); PG8_STAGE(PG8_SB(1, 1), cB + hstep + kstep, voffB);
        PG8_WAIT_V(6); PG8_BAR;
    } else {
        PG8_STAGE(PG8_SB(0, 0), cB, voffB); PG8_STAGE(PG8_SA(0, 0), cA, voffA); PG8_STAGE(PG8_SB(0, 1), cB + hstep, voffB); PG8_STAGE(PG8_SA(0, 1), cA + hstep, voffA);
        if (wr == 1) PG8_BAR;
        PG8_WAIT_V(4); PG8_BAR;
        PG8_STAGE(PG8_SB(1, 0), cB + kstep, voffB); PG8_STAGE(PG8_SA(1, 0), cA + kstep, voffA); PG8_STAGE(PG8_SB(1, 1), cB + hstep + kstep, voffB);
        PG8_WAIT_V(6); PG8_BAR;
    }
    for (;;) {
        const bool has_next = S.next(ui + 1, nxt);
        const char* nA = has_next ? (const char*)g.A + (size_t)nxt.pm * tstep : cA; const char* nB = has_next ? (const char*)g.Bt + (size_t)nxt.pn * tstep : cB;
        for (int t = 0; t < nt; t += 2) {
            const bool last = (t == nt - 2);
            const char* a1 = cA + (size_t)(t + 1) * kstep;
            const char* a2 = last ? nA : cA + (size_t)(t + 2) * kstep; const char* b2 = last ? nB : cB + (size_t)(t + 2) * kstep;
            const char* a3 = a2 + kstep; const char* b3 = b2 + kstep;
            if (last && has_next) S.a_ready(nxt);
            if constexpr (SP2) {
            PG8_LDB(B0, 0, 0); PG8_LDB(B1, 0, 1); PG8_SCHED; PG8_LDA(At, 0, 0); PG8_STAGE(PG8_SA(1, 1), a1 + hstep, voffA);
            PG8_WAIT_V(8); PG8_WAIT_L(0); PG8_BAR; PG8_MMA(0, 0, At, B0); PG8_MMA(0, 1, At, B1); PG8_BAR; PG8_SCHED;
            PG8_LDA(At, 0, 1); PG8_STAGE(PG8_SB(0, 0), b2, voffB); PG8_STAGE(PG8_SB(0, 1), b2 + hstep, voffB); PG8_STAGE(PG8_SA(0, 0), a2, voffA);
            PG8_WAIT_V(8); PG8_WAIT_L(0); PG8_BAR; PG8_MMA(1, 0, At, B0); PG8_MMA(1, 1, At, B1); PG8_BAR; PG8_SCHED;
            PG8_LDB(B0, 1, 0); PG8_LDB(B1, 1, 1); PG8_SCHED; PG8_LDA(At, 1, 0); PG8_STAGE(PG8_SA(0, 1), a2 + hstep, voffA);
            PG8_WAIT_V(8); PG8_WAIT_L(0); PG8_BAR; PG8_MMA(0, 0, At, B0); PG8_MMA(0, 1, At, B1); PG8_BAR; PG8_SCHED;
            PG8_LDA(At, 1, 1); PG8_STAGE(PG8_SB(1, 0), b3, voffB); PG8_STAGE(PG8_SB(1, 1), b3 + hstep, voffB); PG8_STAGE(PG8_SA(1, 0), a3, voffA);
            PG8_WAIT_V(8); PG8_WAIT_L(0); PG8_BAR; PG8_MMA(1, 0, At, B0); PG8_MMA(1, 1, At, B1); PG8_BAR; PG8_SCHED;
            } else {
            PG8_LDB(B0, 0, 0); PG8_SCHED; PG8_LDA(At, 0, 0); PG8_STAGE(PG8_SA(1, 1), a1 + hstep, voffA);
            PG8_WAIT_L(8); PG8_BAR; PG8_WAIT_L(0); PG8_MMA(0, 0, At, B0); PG8_BAR; PG8_SCHED;
            PG8_LDB(B1, 0, 1); PG8_STAGE(PG8_SB(0, 0), b2, voffB);
            PG8_BAR; PG8_WAIT_L(0); PG8_MMA(0, 1, At, B1); PG8_BAR;
            PG8_LDA(At, 0, 1); PG8_STAGE(PG8_SA(0, 0), a2, voffA);
            PG8_BAR; PG8_WAIT_L(0); PG8_MMA(1, 0, At, B0); PG8_BAR; PG8_SCHED;
            PG8_STAGE(PG8_SB(0, 1), b2 + hstep, voffB);
            PG8_WAIT_V(6); PG8_BAR; PG8_MMA(1, 1, At, B1); PG8_BAR;
            PG8_LDB(B0, 1, 0); PG8_SCHED; PG8_LDA(At, 1, 0); PG8_STAGE(PG8_SA(0, 1), a2 + hstep, voffA);
            PG8_WAIT_L(8); PG8_BAR; PG8_WAIT_L(0); PG8_MMA(0, 0, At, B0); PG8_BAR; PG8_SCHED;
            PG8_LDB(B1, 1, 1); PG8_STAGE(PG8_SB(1, 0), b3, voffB);
            PG8_BAR; PG8_WAIT_L(0); PG8_MMA(0, 1, At, B1); PG8_BAR;
            PG8_LDA(At, 1, 1); PG8_STAGE(PG8_SA(1, 0), a3, voffA);
            PG8_BAR; PG8_WAIT_L(0); PG8_MMA(1, 0, At, B0); PG8_BAR; PG8_SCHED;
            PG8_STAGE(PG8_SB(1, 1), b3 + hstep, voffB);
            PG8_WAIT_V(6); PG8_BAR; PG8_MMA(1, 1, At, B1); PG8_BAR;
            }
        }
        if constexpr (ALIGN_EPI) { if (wr == 0) PG8_BAR; }
        if constexpr (!Epi::AFTER_DRAIN) { E(acc, cur, wr, wc, fr, fq); S.done(cur); }
        if (!has_next) break;
#pragma unroll
        for (int a = 0; a < 2; ++a)
#pragma unroll
            for (int b = 0; b < 2; ++b)
#pragma unroll
                for (int m = 0; m < 4; ++m)
#pragma unroll
                    for (int n = 0; n < 2; ++n) acc[a][b][m][n] = (f32x4){0.f, 0.f, 0.f, 0.f};
        cur = nxt; cA = nA; cB = nB; ++ui;
        if constexpr (ALIGN_EPI) { if (wr == 1) PG8_BAR; }
    }
    PG8_WAIT_V(0);
    if constexpr (!ALIGN_EPI) { if (wr == 0) PG8_BAR; }
    PG8_BAR;
    if constexpr (Epi::AFTER_DRAIN) { E.fused(acc, cur, wr, wc, fr, fq, lds, wid, lane); S.done(cur); }
#undef PG8_SA
#undef PG8_SB
#undef PG8_STAGE
#undef PG8_LDA
#undef PG8_LDB
#undef PG8_MMA
#undef PG8_WAIT_V
#undef PG8_WAIT_L
#undef PG8_BAR
#undef PG8_SCHED
}
}

#define GAS __attribute__((address_space(1)))
#define LAS __attribute__((address_space(3)))
typedef unsigned short bf16;
typedef unsigned v4u __attribute__((ext_vector_type(4)));
typedef float f32x4 __attribute__((ext_vector_type(4)));
typedef short bf16x8 __attribute__((ext_vector_type(8)));
typedef GAS unsigned gu32;
typedef GAS unsigned long long gu64;
#define RLX_AGENT __ATOMIC_RELAXED, __HIP_MEMORY_SCOPE_AGENT
#define LDS_WAIT() asm volatile("s_waitcnt lgkmcnt(0)" ::: "memory")
#define VM_WAIT() asm volatile("s_waitcnt vmcnt(0)" ::: "memory")
__device__ __forceinline__ unsigned long long rt() { return __builtin_amdgcn_s_memrealtime(); }
__device__ __forceinline__ unsigned f2bf(float f) { unsigned u = __builtin_bit_cast(unsigned, f); return (u + 0x7fffu + ((u >> 16) & 1u)) >> 16; }
__device__ __forceinline__ unsigned pk2(float lo, float hi) { return f2bf(lo) | (f2bf(hi) << 16); }

#define XB_TMO      128
#define XB_XCNT(j)  (256  + 64 * (j))
#define XB_XSUB(j)  (1280 + 64 * (j))
#define XB_XGEN(j)  (2304 + 64 * (j))
#define XB_TOP      3328
#define XB_TOPGEN   3392
#define XCD_BAR_WORDS 3456
#define XB_SPIN_CAP (1u << 18)

__device__ __forceinline__ unsigned xb_ld(unsigned* p)              { return __hip_atomic_load(p, __ATOMIC_RELAXED, __HIP_MEMORY_SCOPE_AGENT); }
__device__ __forceinline__ unsigned xb_add(unsigned* p, unsigned v) { return __hip_atomic_fetch_add(p, v, __ATOMIC_RELAXED, __HIP_MEMORY_SCOPE_AGENT); }
__device__ __forceinline__ unsigned xb_xcc_id() { return (unsigned)__builtin_amdgcn_s_getreg((3 << 11) | 20) & 0xFu; }
#define XB_SPIN(cond, bar) do { unsigned _sp = 0; while (cond) { __builtin_amdgcn_s_sleep(1); \
    if ((++_sp & 255u) == 0u) { if (xb_ld(&(bar)[XB_TMO])) break; if (_sp > XB_SPIN_CAP) { atomicAdd(&(bar)[XB_TMO], 1u); break; } } } } while (0)

struct XcdBarrier {
    unsigned* bar; unsigned x;
    volatile LAS unsigned* st;
};

__device__ __forceinline__ XcdBarrier xcd_barrier_post(unsigned* bar, volatile LAS unsigned* st) {
    XcdBarrier b; b.bar = bar; b.x = xb_xcc_id(); b.st = st;
    if (threadIdx.x == 0) (void)xb_add(&bar[XB_XCNT(b.x)], 1u);
    return b;
}
__device__ __forceinline__ void xcd_barrier_complete(unsigned* bar, unsigned x, unsigned& nloc, unsigned& nx) {
    const unsigned G = gridDim.x * gridDim.y * gridDim.z;
    unsigned sum, cnt, mine, sp = 0u;
    for (;;) {
        sum = 0u; cnt = 0u; mine = 0u;
#pragma unroll
        for (unsigned j = 0; j < 16; ++j) { const unsigned c = xb_ld(&bar[XB_XCNT(j)]); sum += c; cnt += (c > 0u) ? 1u : 0u; mine = (j == x) ? c : mine; }
        if (sum == G) break;
        __builtin_amdgcn_s_sleep(1);
        if ((++sp & 255u) == 0u) { if (xb_ld(&bar[XB_TMO])) break; if (sp > XB_SPIN_CAP) { atomicAdd(&bar[XB_TMO], 1u); break; } }
    }
    nloc = mine > 0u ? mine : 1u; nx = cnt > 0u ? cnt : 1u;
}

__device__ __forceinline__ void xcd_barrier(const XcdBarrier& b) {
    asm volatile("s_waitcnt vmcnt(0)" ::: "memory");
    __syncthreads();
    if (threadIdx.x == 0) {
        unsigned* bar = b.bar;
        __builtin_amdgcn_s_waitcnt(0);
        unsigned nloc = b.st[0], nx = b.st[1];
        if (nloc == 0u) { xcd_barrier_complete(bar, b.x, nloc, nx); b.st[0] = nloc; b.st[1] = nx; }
        const unsigned old = xb_add(&bar[XB_XSUB(b.x)], 1u);
        const unsigned gen = old / nloc;
        if (old + 1u == (gen + 1u) * nloc) {
            __builtin_amdgcn_fence(__ATOMIC_RELEASE, "agent");
            asm volatile("s_waitcnt vmcnt(0)" ::: "memory");
            const unsigned og = xb_add(&bar[XB_TOP], 1u);
            const unsigned tg = og / nx;
            if (og + 1u == (tg + 1u) * nx) xb_add(&bar[XB_TOPGEN], 1u);
            else XB_SPIN(xb_ld(&bar[XB_TOPGEN]) == tg, bar);
            __builtin_amdgcn_fence(__ATOMIC_ACQUIRE, "agent");
            xb_add(&bar[XB_XGEN(b.x)], 1u);
            asm volatile("s_waitcnt vmcnt(0)" ::: "memory");
        } else {
            XB_SPIN(xb_ld(&bar[XB_XGEN(b.x)]) == gen, bar);
            __builtin_amdgcn_fence(__ATOMIC_ACQUIRE, "agent");
            asm volatile("s_waitcnt vmcnt(0)" ::: "memory");
        }
    }
    __syncthreads();
}

#include <hip/hip_bf16.h>
#include <cmath>
namespace dattn {
using bf16=__hip_bfloat16;
using bf16x8=__attribute__((ext_vector_type(8)))short;
using s16x4=__attribute__((ext_vector_type(4)))short;
using f32x16=__attribute__((ext_vector_type(16)))float;
using u32x4=__attribute__((ext_vector_type(4)))unsigned;
constexpr int SEQ=2048,D=64,DM=512;
constexpr int NW=8,QBLK=32,QB=QBLK*NW,KVBLK=64;
constexpr int OPITCH=1024;
__device__ __forceinline__ int crow(int r,int hi){return (r&3)+8*(r>>2)+4*hi;}
#define SBAR() __builtin_amdgcn_sched_barrier(0)
__device__ __forceinline__ void cmask(f32x16&p0,f32x16&p1,int jb,int qrel,int hi){
  const float NEG=-INFINITY; int kb=64*jb+4*hi;
  #pragma unroll
  for(int r=0;r<16;++r){int kv=kb+(r&3)+8*(r>>2); if(kv>qrel)p0[r]=NEG; if(kv+32>qrel)p1[r]=NEG;}
}
constexpr int NSLOT=3, SLOTB=8192;
constexpr int LDS_K=0, LDS_V=NSLOT*SLOTB, LDS_WS=2*NSLOT*SLOTB, LDS_OST=LDS_WS+NW*64*4, LDS_BYTES=LDS_OST+NW*4096;
__device__ __forceinline__ void glds16(const void*gsrc,unsigned lds_dst){unsigned keep;
  asm volatile("s_mov_b32 %0, m0\n\ts_mov_b32 m0, %2\n\ts_nop 0\n\tglobal_load_lds_dwordx4 %1, off\n\ts_mov_b32 m0, %0":"=&s"(keep):"v"(gsrc),"s"(lds_dst):"memory");}
__device__ __forceinline__ float max3f(float a,float b,float c){float r;asm("v_max3_f32 %0, %1, %2, %3":"=v"(r):"v"(a),"v"(b),"v"(c));return r;}
__device__ __forceinline__ float max2f(float a,float b){float r;asm("v_max_f32_e32 %0, %1, %2":"=v"(r):"v"(a),"v"(b));return r;}
__device__ __forceinline__ float fsub_s(float a,float b){float r;asm("v_sub_f32_e32 %0, %1, %2":"=v"(r):"v"(a),"v"(b));return r;}
typedef float f32x2_t __attribute__((ext_vector_type(2))); typedef __bf16 bf16x2_t __attribute__((ext_vector_type(2)));
__device__ __forceinline__ unsigned cvtpk_s(float lo,float hi){f32x2_t v={lo,hi};bf16x2_t b=__builtin_convertvector(v,bf16x2_t);return __builtin_bit_cast(unsigned,b);}
#define WAIT_BAR(N) asm volatile("s_waitcnt vmcnt(" #N ") lgkmcnt(0)\n\ts_barrier":::"memory")
__device__ __forceinline__ void bias_init(f32x16&x,float a,float s2){
  #pragma unroll
  for(int r=0;r<16;++r)x[r]=__builtin_fmaf(s2,(float)((r&3)+8*(r>>2)),a);
}
__device__ __forceinline__ void qkt(f32x16&p0,f32x16&p1,const char*Kslot,const bf16x8*qr,int r32,int hi){
  const char*kb=Kslot+hi*1024+r32*16;
  #pragma unroll
  for(int d0=0;d0<4;++d0){
    const bf16x8 b0=*reinterpret_cast<const bf16x8*>(kb+d0*2048);
    const bf16x8 b1=*reinterpret_cast<const bf16x8*>(kb+d0*2048+512);
    p0=__builtin_amdgcn_mfma_f32_32x32x16_bf16(b0,qr[d0],p0,0,0,0);p1=__builtin_amdgcn_mfma_f32_32x32x16_bf16(b1,qr[d0],p1,0,0,0);}
}
typedef __attribute__((address_space(3))) const char* lds_cptr;
typedef short v4i16_t __attribute__((ext_vector_type(4)));
__device__ __forceinline__ void kload8(bf16x8*kf,lds_cptr kp){
  kf[0]=*(const __attribute__((address_space(3))) bf16x8*)(kp);      kf[1]=*(const __attribute__((address_space(3))) bf16x8*)(kp+512);
  kf[2]=*(const __attribute__((address_space(3))) bf16x8*)(kp+2048); kf[3]=*(const __attribute__((address_space(3))) bf16x8*)(kp+2560);
  kf[4]=*(const __attribute__((address_space(3))) bf16x8*)(kp+4096); kf[5]=*(const __attribute__((address_space(3))) bf16x8*)(kp+4608);
  kf[6]=*(const __attribute__((address_space(3))) bf16x8*)(kp+6144); kf[7]=*(const __attribute__((address_space(3))) bf16x8*)(kp+6656);
}
__device__ __forceinline__ void kload2(bf16x8*kf,lds_cptr kp,int j){ kf[2*j]=*(const __attribute__((address_space(3))) bf16x8*)(kp+j*2048); kf[2*j+1]=*(const __attribute__((address_space(3))) bf16x8*)(kp+j*2048+512); }
__device__ __forceinline__ s16x4 vtr(lds_cptr p){ return __builtin_bit_cast(s16x4,__builtin_amdgcn_ds_read_tr16_b64_v4i16((__attribute__((address_space(3))) v4i16_t*)p)); }
__device__ __forceinline__ float rowmax(const f32x16&p0,const f32x16&p1){
  float a=max3f(p0[0],p0[1],p1[0]),b=max3f(p0[2],p0[3],p1[1]);a=max3f(a,p1[2],p1[3]);
  #pragma unroll
  for(int r=4;r<16;r+=4){a=max3f(a,p0[r],p0[r+1]);b=max3f(b,p0[r+2],p0[r+3]);a=max3f(a,p1[r],p1[r+1]);b=max3f(b,p1[r+2],p1[r+3]);}
  const float m=max2f(a,b);
  auto rr=__builtin_amdgcn_permlane32_swap(__float_as_uint(m),__float_as_uint(m),false,false);
  return max2f(__uint_as_float(rr[0]),__uint_as_float(rr[1]));
}
__device__ __forceinline__ void pv(f32x16*o,int vb,bf16x8 pa0,bf16x8 pa1,bf16x8 pa2,bf16x8 pa3){
  #pragma unroll
  for(int d0=0;d0<2;++d0){s16x4 lo[4],hi[4];
    #pragma unroll
    for(int ks=0;ks<4;++ks){
      asm volatile("ds_read_b64_tr_b16 %0,%1 offset:%c2":"=&v"(lo[ks]):"v"(vb),"i"(d0*4096+ks*1024):"memory");
      asm volatile("ds_read_b64_tr_b16 %0,%1 offset:%c2":"=&v"(hi[ks]):"v"(vb),"i"(d0*4096+ks*1024+512):"memory");}
    asm volatile("s_waitcnt lgkmcnt(0)":::"memory");SBAR();
    #define PK(k) (bf16x8){lo[k][0],lo[k][1],lo[k][2],lo[k][3],hi[k][0],hi[k][1],hi[k][2],hi[k][3]}
    o[d0]=__builtin_amdgcn_mfma_f32_32x32x16_bf16(pa0,PK(0),o[d0],0,0,0);
    o[d0]=__builtin_amdgcn_mfma_f32_32x32x16_bf16(pa1,PK(1),o[d0],0,0,0);
    o[d0]=__builtin_amdgcn_mfma_f32_32x32x16_bf16(pa2,PK(2),o[d0],0,0,0);
    o[d0]=__builtin_amdgcn_mfma_f32_32x32x16_bf16(pa3,PK(3),o[d0],0,0,0);
    #undef PK
  }
}
__device__ __forceinline__ float half_sum(float v){
  #pragma unroll
  for(int o=1;o<32;o<<=1)v+=__shfl_xor(v,o);
  return v;
}

template<int THRL> __device__ __forceinline__ void attn_sub(int b,int h,int qb,int vh,int c,const bf16*PQ,const bf16*__restrict__ PK,const bf16*__restrict__ PV,unsigned short*MIX,float*ssqa,float lam,char*shm){
  int tid_=threadIdx.x; asm volatile("":"+v"(tid_));
  const int tid=tid_,lane=tid&63,r32=lane&31,hi=lane>>5; const int wid=__builtin_amdgcn_readfirstlane(tid>>6);
  const long rowbase=(long)b*SEQ; const int q0=qb*QB;
  const bf16*Qw=PQ+(rowbase+q0+wid*QBLK)*DM+h*128+c*64;
  const bf16*Kh=PK+rowbase*DM+h*128+c*64,*Vh=PV+rowbase*DM+h*128+vh*64;
  const unsigned lds0=(unsigned)(uintptr_t)shm;
  float*wsf=(float*)(shm+LDS_WS)+wid*64;
  const int NT=(q0+QB)/KVBLK;
  const bf16*ksrc=Kh+(long)lane*DM+wid*8+(long)(NT-1)*KVBLK*DM;
  const bf16*vsrc=Vh+(long)(16*(wid&3)+(lane>>2))*DM+(wid>>2)*32+(lane&3)*8+(long)(NT-1)*KVBLK*DM;
  const unsigned kdst=lds0+LDS_K+wid*1024, vdst=lds0+LDS_V+wid*1024;
  #define DMA_K(t,slot) glds16(ksrc-(long)(t)*KVBLK*DM,(unsigned)__builtin_amdgcn_readfirstlane(kdst+(slot)))
  #define DMA_V(t,slot) glds16(vsrc-(long)(t)*KVBLK*DM,(unsigned)__builtin_amdgcn_readfirstlane(vdst+(slot)))
  const int vb0=(int)(lds0+LDS_V)+((lane>>4)&1)*32+(lane&3)*8+(4*hi+((lane&15)>>2))*64;
  const char*Kbase=shm+LDS_K; bf16x8 kf[8];
  const lds_cptr shm3=(lds_cptr)shm; const lds_cptr kp0=shm3+LDS_K+hi*1024+r32*16; const lds_cptr vp0=shm3+LDS_V+((lane>>4)&1)*32+(lane&3)*8+(4*hi+((lane&15)>>2))*64;
  DMA_K(0,0);DMA_V(0,0);DMA_K(1,SLOTB);
  bf16x8 qr[4];
  #pragma unroll
  for(int d0=0;d0<4;++d0)qr[d0]=*reinterpret_cast<const bf16x8*>(&Qw[(long)r32*DM+d0*16+hi*8]);
  float mhat=0.f,l_reg=0.f;f32x16 o[2];o[0]=f32x16{};o[1]=f32x16{};
  const int qrel=wid*QBLK+r32;
  const float s2=__builtin_amdgcn_exp2f(-2.f*(float)(h+1))*1.4426950408889634f;
  const float ab0=s2*(float)(192+4*hi-qrel);
  #define CMASK(P0,P1,t) do{int jb_=3-(t); if(jb_>=0)cmask(P0,P1,jb_,qrel,hi);}while(0)
  bool resc=false;
  #define RESC() do{ if(resc){ asm volatile("s_waitcnt lgkmcnt(0)":::"memory"); \
      _Pragma("unroll") for(int d_=0;d_<2;++d_) _Pragma("unroll") for(int r=0;r<16;++r)o[d_][r]*=wsf[crow(r,hi)]; } }while(0)
  f32x16 pA0,pA1,pB0,pB1;
  int sl_prev=0,sl_cur=0,sl_next=SLOTB;
  #define ROT() do{sl_prev=sl_cur;sl_cur=sl_next;sl_next=(sl_next==(NSLOT-1)*SLOTB)?0:sl_next+SLOTB;}while(0)
  DMA_K(2,2*SLOTB);
  WAIT_BAR(3);
  bias_init(pA0,ab0,s2); bias_init(pA1,ab0+32.f*s2,s2);
  qkt(pA0,pA1,Kbase,qr,r32,hi);asm volatile("s_nop 15\n\ts_nop 7":"+v"(pA0),"+v"(pA1));CMASK(pA0,pA1,0);
  { const float rm=rowmax(pA0,pA1); const float dl=__builtin_fmaxf(rm,-1024.f); mhat=dl;
    _Pragma("unroll") for(int r=0;r<16;++r){pA0[r]=fsub_s(pA0[r],dl);pA1[r]=fsub_s(pA1[r],dl);}
    _Pragma("unroll") for(int r=0;r<16;++r)pA0[r]=__builtin_amdgcn_exp2f(pA0[r]); }
  _Pragma("unroll") for(int r=0;r<16;++r)pA1[r]=__builtin_amdgcn_exp2f(pA1[r]);
  WAIT_BAR(0);
  DMA_K(3,0);DMA_V(1,SLOTB);
  ROT();
  kload8(kf,kp0+sl_cur);
  WAIT_BAR(2);
  s16x4 vlo[8],vhi[8]; u32x4 pw0,pw1,pw2,pw3;
  #define PKW(P,B) cvtpk_s(P[B],P[B+1])
  #define PAF(k) __builtin_bit_cast(bf16x8,pw##k)
  #define VFR(i) (bf16x8){vlo[i][0],vlo[i][1],vlo[i][2],vlo[i][3],vhi[i][0],vhi[i][1],vhi[i][2],vhi[i][3]}
  #define PIN(x) asm volatile("":"+v"(x))
  #define MX3(a,b,c) __builtin_fmaxf(__builtin_fmaxf((a),(b)),(c))
  #define GAPA(MF,A0,A1,A2,A3,W0,W1,PW) do{ MF; sacc+=A0; sacc+=A1; sacc+=A2; sacc+=A3; PIN(sacc); W0; W1; PIN(PW); SBAR(); }while(0)
  #define EX(v) __builtin_amdgcn_exp2f(v)
  #define GAPB(MF,X,B) do{ MF; X[B]=EX(X[B]); X[B+1]=EX(X[B+1]); X[B+2]=EX(X[B+2]); X[B+3]=EX(X[B+3]); PIN(X); SBAR(); }while(0)
  #define VRD(i) do{ vlo[i]=vtr(vp_+(((i)>>2)*4096+((i)&3)*1024)); vhi[i]=vtr(vp_+(((i)>>2)*4096+((i)&3)*1024+512)); }while(0)
  #define KRD(G,j) do{ if(G){ kload2(kf,kp0+sl_next,j); SBAR(); } }while(0)
  #define STEP(C0,C1,P0,P1,t,GK,GV,GL) do{ SBAR(); \
    const lds_cptr vp_=vp0+sl_prev; \
    const float a0_=__builtin_fmaf(-64.f*s2,(float)(t),ab0)-mhat; \
    bias_init(C0,a0_,s2); bias_init(C1,a0_+32.f*s2,s2); SBAR(); \
    VRD(0); SBAR(); float sacc=(P0[0]+P0[1]); \
    GAPA(C0=__builtin_amdgcn_mfma_f32_32x32x16_bf16(kf[0],qr[0],C0,0,0,0), P0[2],P0[3],P0[4],P0[5],     pw0[0]=PKW(P0,0), pw0[1]=PKW(P0,2), pw0); \
    VRD(4); SBAR(); GAPA(C1=__builtin_amdgcn_mfma_f32_32x32x16_bf16(kf[1],qr[0],C1,0,0,0), P0[6],P0[7],P0[8],P0[9],     pw0[2]=PKW(P0,4), pw0[3]=PKW(P0,6), pw0); \
    VRD(1); SBAR(); GAPA(C0=__builtin_amdgcn_mfma_f32_32x32x16_bf16(kf[2],qr[1],C0,0,0,0),   P0[10],P0[11],P0[12],P0[13], pw1[0]=PKW(P0,8), pw1[1]=PKW(P0,10), pw1); \
    VRD(5); SBAR(); GAPA(C1=__builtin_amdgcn_mfma_f32_32x32x16_bf16(kf[3],qr[1],C1,0,0,0),   P0[14],P0[15],P1[0],P1[1],   pw1[2]=PKW(P0,12),pw1[3]=PKW(P0,14), pw1); \
    VRD(2); SBAR(); GAPA(C0=__builtin_amdgcn_mfma_f32_32x32x16_bf16(kf[4],qr[2],C0,0,0,0),   P1[2],P1[3],P1[4],P1[5],     pw2[0]=PKW(P1,0), pw2[1]=PKW(P1,2), pw2); \
    VRD(6); SBAR(); GAPA(C1=__builtin_amdgcn_mfma_f32_32x32x16_bf16(kf[5],qr[2],C1,0,0,0),   P1[6],P1[7],P1[8],P1[9],     pw2[2]=PKW(P1,4), pw2[3]=PKW(P1,6), pw2); \
    VRD(3); SBAR(); GAPA(C0=__builtin_amdgcn_mfma_f32_32x32x16_bf16(kf[6],qr[3],C0,0,0,0),   P1[10],P1[11],P1[12],P1[13], pw3[0]=PKW(P1,8), pw3[1]=PKW(P1,10), pw3); \
    VRD(7); SBAR(); GAPA(C1=__builtin_amdgcn_mfma_f32_32x32x16_bf16(kf[7],qr[3],C1,0,0,0),   P1[14],P1[15],0.f,0.f,       pw3[2]=PKW(P1,12),pw3[3]=PKW(P1,14), pw3); \
    l_reg+=sacc; \
    if(GK){DMA_K((t)+3,sl_cur);} if(GV){DMA_V((t)+1,sl_next);} \
    CMASK(C0,C1,t); \
    { float a=MX3(C0[0],C0[1],C1[0]),b=MX3(C0[2],C0[3],C1[1]); a=MX3(a,C1[2],C1[3]); \
      _Pragma("unroll") for(int r=4;r<16;r+=4){a=MX3(a,C0[r],C0[r+1]);b=MX3(b,C0[r+2],C0[r+3]);a=MX3(a,C1[r],C1[r+1]);b=MX3(b,C1[r+2],C1[r+3]);} \
      float rm=__builtin_fmaxf(a,b); { auto rr=__builtin_amdgcn_permlane32_swap(__float_as_uint(rm),__float_as_uint(rm),false,false); rm=__builtin_fmaxf(__uint_as_float(rr[0]),__uint_as_float(rr[1])); } \
      resc=false; \
      if(__builtin_expect(__any(rm>(float)THRL),0)){ const float dl=__builtin_fmaxf(rm,0.f); mhat+=dl; \
        _Pragma("unroll") for(int r=0;r<16;++r){C0[r]-=dl;C1[r]-=dl;} \
        const float f=__builtin_amdgcn_exp2f(-dl); l_reg*=f; if(hi==0)wsf[r32]=f; resc=true; } } \
    SBAR(); \
    GAPB(o[0]=__builtin_amdgcn_mfma_f32_32x32x16_bf16(PAF(0),VFR(0),o[0],0,0,0), C0,0); \
    GAPB(o[1]=__builtin_amdgcn_mfma_f32_32x32x16_bf16(PAF(0),VFR(4),o[1],0,0,0), C0,4); \
    KRD(GL,0); GAPB(o[0]=__builtin_amdgcn_mfma_f32_32x32x16_bf16(PAF(1),VFR(1),o[0],0,0,0), C0,8); \
    KRD(GL,1); GAPB(o[1]=__builtin_amdgcn_mfma_f32_32x32x16_bf16(PAF(1),VFR(5),o[1],0,0,0), C0,12); \
    KRD(GL,2); GAPB(o[0]=__builtin_amdgcn_mfma_f32_32x32x16_bf16(PAF(2),VFR(2),o[0],0,0,0), C1,0); \
    KRD(GL,3); GAPB(o[1]=__builtin_amdgcn_mfma_f32_32x32x16_bf16(PAF(2),VFR(6),o[1],0,0,0), C1,4); \
    GAPB(o[0]=__builtin_amdgcn_mfma_f32_32x32x16_bf16(PAF(3),VFR(3),o[0],0,0,0), C1,8); \
    GAPB(o[1]=__builtin_amdgcn_mfma_f32_32x32x16_bf16(PAF(3),VFR(7),o[1],0,0,0), C1,12); \
    }while(0)
  int t=1;
  for(;t+5<NT;t+=2){
    STEP(pB0,pB1,pA0,pA1,t,true,true,true);     WAIT_BAR(2); RESC(); ROT();
    STEP(pA0,pA1,pB0,pB1,t+1,true,true,true);   WAIT_BAR(2); RESC(); ROT();
  }
  #define ENDW(tt) do{ if((tt)+3<NT){WAIT_BAR(2);} else if((tt)+2<NT){WAIT_BAR(1);} else {WAIT_BAR(0);} }while(0)
  for(;t+1<NT;t+=2){
    STEP(pB0,pB1,pA0,pA1,t,(t+3<NT),(t+1<NT),(t+1<NT));       ENDW(t);   RESC(); ROT();
    STEP(pA0,pA1,pB0,pB1,t+1,(t+4<NT),(t+2<NT),(t+2<NT));     ENDW(t+1); RESC(); ROT();
  }
  STEP(pB0,pB1,pA0,pA1,NT-1,false,false,false); RESC();
  { float sacc=pB0[0]+pB0[1]; _Pragma("unroll") for(int r=2;r<16;++r)sacc+=pB0[r]; _Pragma("unroll") for(int r=0;r<16;++r)sacc+=pB1[r]; l_reg+=sacc;
    pw0=(u32x4){PKW(pB0,0),PKW(pB0,2),PKW(pB0,4),PKW(pB0,6)};pw1=(u32x4){PKW(pB0,8),PKW(pB0,10),PKW(pB0,12),PKW(pB0,14)};pw2=(u32x4){PKW(pB1,0),PKW(pB1,2),PKW(pB1,4),PKW(pB1,6)};pw3=(u32x4){PKW(pB1,8),PKW(pB1,10),PKW(pB1,12),PKW(pB1,14)};
    SBAR(); pv(o,vb0+sl_cur,PAF(0),PAF(1),PAF(2),PAF(3)); }
  #undef PKW
  #undef PAF
  #undef VFR
  #undef PIN
  #undef MX3
  #undef GAPA
  #undef GAPB
  #undef EX
  #undef VRD
  #undef KRD
  #undef STEP
  #undef ENDW
  {auto rr=__builtin_amdgcn_permlane32_swap(__float_as_uint(l_reg),__float_as_uint(l_reg),false,false);l_reg=__uint_as_float(rr[0])+__uint_as_float(rr[1]);}
  if(hi==0)wsf[32+r32]=l_reg;asm volatile("s_waitcnt lgkmcnt(0)":::"memory");
  #pragma unroll
  for(int r=0;r<16;++r){const float rl=__builtin_amdgcn_rcpf(wsf[32+crow(r,hi)]); o[0][r]*=rl; o[1][r]*=rl;}
  unsigned*stB=(unsigned*)(shm+LDS_OST)+wid*1024+lane;
  if(c==0){
    #pragma unroll
    for(int r=0;r<16;++r)stB[r*64]=cvtpk_s(o[0][r],o[1][r]);
  } else {
    f32x16 d0v,d1v;
    #pragma unroll
    for(int r=0;r<16;++r){const unsigned w=stB[r*64]; d0v[r]=__builtin_bit_cast(float,w<<16)-lam*o[0][r]; d1v[r]=__builtin_bit_cast(float,w&0xffff0000u)-lam*o[1][r];}
    float*sq=ssqa+(size_t)(rowbase+q0+wid*QBLK)*8+h*2+vh;
    #pragma unroll
    for(int r=0;r<16;++r){const float s=half_sum(d0v[r]*d0v[r]+d1v[r]*d1v[r]); if(r32==0)sq[crow(r,hi)*8]=s;}
    unsigned short*Ow=MIX+(rowbase+q0+wid*QBLK)*OPITCH+512+h*128+vh*64;
    unsigned short*stg=(unsigned short*)(shm+LDS_OST)+wid*2048;
    asm volatile("s_waitcnt lgkmcnt(0)":::"memory");
    #pragma unroll
    for(int r=0;r<16;++r){const int orow=crow(r,hi);
      stg[orow*64+r32]=(unsigned short)(cvtpk_s(d0v[r],0.f)&0xffffu); stg[orow*64+32+r32]=(unsigned short)(cvtpk_s(d1v[r],0.f)&0xffffu);}
    asm volatile("s_waitcnt lgkmcnt(0)":::"memory");
    #pragma unroll
    for(int i=0;i<4;++i){const int row=i*8+(lane>>3),ch=lane&7; const u32x4 v=*(const u32x4*)(stg+row*64+ch*8); *(u32x4*)(Ow+(long)row*OPITCH+ch*8)=v;}
  }
  asm volatile("s_waitcnt lgkmcnt(0)\n\ts_barrier":::"memory");
  #undef DMA_K
  #undef DMA_V
  #undef CMASK
  #undef RESC
  #undef ROT
}
#undef SBAR
#undef WAIT_BAR
}

namespace dec {
typedef float f32x4 __attribute__((ext_vector_type(4)));
constexpr int PAST = 8192, PAGE = 128, NPG = 64, MP = 16384;
constexpr int PART_FLOATS = 16 * 128 + 32;
constexpr int LDS_MRG_BYTES = 4 * (32 * 64 * 4 + 256);
__device__ __forceinline__ float xrow16_max(float x) {
    auto s = __builtin_amdgcn_permlane16_swap(__float_as_uint(x), __float_as_uint(x), false, false);
    x = fmaxf(__uint_as_float(s[0]), __uint_as_float(s[1]));
    auto t = __builtin_amdgcn_permlane32_swap(__float_as_uint(x), __float_as_uint(x), false, false);
    return fmaxf(__uint_as_float(t[0]), __uint_as_float(t[1]));
}
__device__ __forceinline__ float xrow16_sum(float x) {
    auto s = __builtin_amdgcn_permlane16_swap(__float_as_uint(x), __float_as_uint(x), false, false);
    x = __uint_as_float(s[0]) + __uint_as_float(s[1]);
    auto t = __builtin_amdgcn_permlane32_swap(__float_as_uint(x), __float_as_uint(x), false, false);
    return __uint_as_float(t[0]) + __uint_as_float(t[1]);
}
struct KV { f32x4 k[8]; f32x4 v[4][2]; };
__device__ __forceinline__ void load_kv(KV& d, const float* kb, const float* vb) {
#pragma unroll
    for (int t = 0; t < 8; ++t) d.k[t] = __builtin_nontemporal_load((const f32x4*)(kb + 16 * t));
#pragma unroll
    for (int j = 0; j < 4; ++j)
#pragma unroll
        for (int hf = 0; hf < 2; ++hf) d.v[j][hf] = __builtin_nontemporal_load((const f32x4*)(vb + j * 512 + hf * 64));
}
__device__ __forceinline__ void dec_item(int bd, int p0, int np, const unsigned short* PQ, const float* ck, const float* cv, const int* pt, float* part, char* shm) {
    int tid_ = threadIdx.x; asm volatile("" : "+v"(tid_));
    const int tid = tid_, lane = tid & 63, n = lane & 15, kq = lane >> 4; const int wid = __builtin_amdgcn_readfirstlane(tid >> 6);
    const int h = wid & 3, half = wid >> 2;
    const float s2 = __builtin_amdgcn_exp2f(-2.f * (float)(h + 1)) * 1.4426950408889634f;
    unsigned qpk[8][2];
    { const unsigned short* qrow = PQ + (size_t)(MP + bd * 8 + (n & 7)) * 512 + h * 128 + 4 * kq;
#pragma unroll
      for (int t = 0; t < 8; ++t) { const uint2 w = *(const uint2*)(qrow + 16 * t); const bool on = ((t >> 2) == (n >> 3)); qpk[t][0] = on ? w.x : 0u; qpk[t][1] = on ? w.y : 0u; } }
#define QR(t, r) __builtin_bit_cast(float, ((r) & 1) ? (qpk[t][(r) >> 1] & 0xffff0000u) : (qpk[t][(r) >> 1] << 16))
    f32x4 O[8];
#pragma unroll
    for (int i = 0; i < 8; ++i) O[i] = (f32x4){0.f, 0.f, 0.f, 0.f};
    float m_run = -INFINITY, l_run = 0.f;
    const int NS = np * 4;
    const size_t koff = ((size_t)(half * 64 + n) * 4 + h) * 128 + 4 * kq;
    const size_t voff = ((size_t)(half * 64 + 4 * kq) * 4 + h) * 128 + 4 * n;
    const float sbl = s2 * (float)(half * 64 + 4 * kq - PAST - (n & 7));
    const int ptv = (lane < np) ? pt[bd * NPG + p0 + lane] : 0;
#define DEC_BASES(i_, KB_, VB_) const int pg_##i_ = __builtin_amdgcn_readlane(ptv, (i_) >> 2); \
    const float* KB_ = ck + (size_t)pg_##i_ * (PAGE * 512) + (size_t)((i_) & 3) * (16 * 512) + koff; const float* VB_ = cv + (size_t)pg_##i_ * (PAGE * 512) + (size_t)((i_) & 3) * (16 * 512) + voff
#define DEC_STEP(B_, i_) do { \
        f32x4 a0 = (f32x4){0.f, 0.f, 0.f, 0.f}, a1 = (f32x4){0.f, 0.f, 0.f, 0.f}; \
        _Pragma("unroll") for (int t = 0; t < 8; t += 2) _Pragma("unroll") for (int r = 0; r < 4; ++r) { \
            a0 = __builtin_amdgcn_mfma_f32_16x16x4f32(B_.k[t][r], QR(t, r), a0, 0, 0, 0); a1 = __builtin_amdgcn_mfma_f32_16x16x4f32(B_.k[t + 1][r], QR(t + 1, r), a1, 0, 0, 0); } \
        const float sb = sbl + s2 * (float)((p0 + ((i_) >> 2)) * PAGE + ((i_) & 3) * 16); \
        float sv[4]; _Pragma("unroll") for (int v = 0; v < 4; ++v) sv[v] = (a0[v] + a1[v]) + (sb + s2 * (float)v); \
        float mx = fmaxf(fmaxf(sv[0], sv[1]), fmaxf(sv[2], sv[3])); mx = xrow16_max(mx); \
        const float mn = fmaxf(m_run, mx), alpha = __builtin_amdgcn_exp2f(m_run - mn); m_run = mn; \
        float p[4]; _Pragma("unroll") for (int v = 0; v < 4; ++v) p[v] = __builtin_amdgcn_exp2f(sv[v] - mn); \
        l_run = l_run * alpha + ((p[0] + p[1]) + (p[2] + p[3])); \
        float ao[4]; _Pragma("unroll") for (int v = 0; v < 4; ++v) ao[v] = __shfl(alpha, 4 * kq + v); \
        _Pragma("unroll") for (int i = 0; i < 8; ++i) _Pragma("unroll") for (int v = 0; v < 4; ++v) O[i][v] *= ao[v]; \
        _Pragma("unroll") for (int j = 0; j < 4; ++j) _Pragma("unroll") for (int hf = 0; hf < 2; ++hf) _Pragma("unroll") for (int r = 0; r < 4; ++r) \
            O[hf * 4 + r] = __builtin_amdgcn_mfma_f32_16x16x4f32(p[j], B_.v[j][hf][r], O[hf * 4 + r], 0, 0, 0); \
    } while (0)
    KV A, B;
    { DEC_BASES(0, kb0, vb0); load_kv(A, kb0, vb0); }
    __builtin_amdgcn_sched_barrier(0);
    for (int i = 0; i < NS; i += 2) {
        { const int i1 = i + 1; DEC_BASES(i1, kb1, vb1); load_kv(B, kb1, vb1); }
        __builtin_amdgcn_sched_barrier(0);
        DEC_STEP(A, i);
        __builtin_amdgcn_sched_barrier(0);
        if (i + 2 < NS) { const int i2 = i + 2; DEC_BASES(i2, kb2, vb2); load_kv(A, kb2, vb2); }
        __builtin_amdgcn_sched_barrier(0);
        DEC_STEP(B, (i + 1));
        __builtin_amdgcn_sched_barrier(0);
    }
#undef DEC_BASES
#undef DEC_STEP
#undef QR
    l_run = xrow16_sum(l_run);
    float* mo = (float*)(shm + h * (32 * 64 * 4 + 256)); float* mml = mo + 32 * 64;
    if (half == 1) {
#pragma unroll
        for (int i = 0; i < 8; ++i)
#pragma unroll
            for (int v = 0; v < 4; ++v) mo[(i * 4 + v) * 64 + lane] = O[i][v];
        if (lane < 16) { mml[lane] = m_run; mml[16 + lane] = l_run; }
    }
    asm volatile("s_waitcnt lgkmcnt(0)" ::: "memory"); __builtin_amdgcn_s_barrier(); asm volatile("" ::: "memory");
    if (half == 0) {
        const float m1 = mml[n], l1 = mml[16 + n];
        const float M = fmaxf(m_run, m1), w0 = __builtin_amdgcn_exp2f(m_run - M), w1 = __builtin_amdgcn_exp2f(m1 - M);
        const float L = w0 * l_run + w1 * l1;
        float* rec = part + (size_t)h * PART_FLOATS;
        if (lane < 16) { rec[2048 + lane] = M; rec[2064 + lane] = L; }
#pragma unroll
        for (int v = 0; v < 4; ++v) { const float a = __shfl(w0, 4 * kq + v), b = __shfl(w1, 4 * kq + v);
#pragma unroll
            for (int hf = 0; hf < 2; ++hf) { f32x4 o;
#pragma unroll
                for (int r = 0; r < 4; ++r) o[r] = a * O[hf * 4 + r][v] + b * mo[((hf * 4 + r) * 4 + v) * 64 + lane];
                *(f32x4*)(rec + (4 * kq + v) * 128 + hf * 64 + 4 * n) = o; } }
    }
    asm volatile("s_waitcnt lgkmcnt(0)" ::: "memory"); __builtin_amdgcn_s_barrier(); asm volatile("" ::: "memory");
}
__device__ __forceinline__ float wsum(float v) {
#pragma unroll
    for (int o = 1; o < 64; o <<= 1) v += __shfl_xor(v, o);
    return v;
}
__device__ __forceinline__ void dec_combine(int rs, int h, int npart, const float* part_seq  ,
                                            const unsigned short* PQ, const unsigned short* PK, const unsigned short* PV, float lam, const float* subg, unsigned short* MIX, int lane) {
    const int bd = rs >> 3, qi = rs & 7;
    const float s2 = __builtin_amdgcn_exp2f(-2.f * (float)(h + 1)) * 1.4426950408889634f;
    float oc[2][2];
#pragma unroll
    for (int c = 0; c < 2; ++c) {
        const int row = c * 8 + qi;
        const float q = __builtin_bit_cast(float, (unsigned)PQ[(size_t)(MP + rs) * 512 + h * 128 + c * 64 + lane] << 16);
        float sn[8]; float M = -INFINITY;
#pragma unroll
        for (int tn = 0; tn < 8; ++tn) { sn[tn] = -INFINITY;
            if (tn <= qi) { const float k = __builtin_bit_cast(float, (unsigned)PK[(size_t)(MP + bd * 8 + tn) * 512 + h * 128 + c * 64 + lane] << 16);
                sn[tn] = wsum(q * k) - s2 * (float)(qi - tn); M = fmaxf(M, sn[tn]); } }
        for (int i = 0; i < npart; ++i) M = fmaxf(M, part_seq[((size_t)i * 4 + h) * PART_FLOATS + 2048 + row]);
        float L = 0.f, ox = 0.f, oy = 0.f;
        for (int i = 0; i < npart; ++i) { const float* rec = part_seq + ((size_t)i * 4 + h) * PART_FLOATS;
            const float w = __builtin_amdgcn_exp2f(rec[2048 + row] - M); const float2 ov = *(const float2*)(rec + row * 128 + 2 * lane);
            L += w * rec[2064 + row]; ox += w * ov.x; oy += w * ov.y; }
#pragma unroll
        for (int tn = 0; tn < 8; ++tn) if (tn <= qi) { const float p = __builtin_amdgcn_exp2f(sn[tn] - M);
            const unsigned w = *(const unsigned*)(PV + (size_t)(MP + bd * 8 + tn) * 512 + h * 128 + 2 * lane);
            L += p; ox += p * __builtin_bit_cast(float, w << 16); oy += p * __builtin_bit_cast(float, w & 0xffff0000u); }
        oc[c][0] = ox / L; oc[c][1] = oy / L;
    }
    const float dx = oc[0][0] - lam * oc[1][0], dy = oc[0][1] - lam * oc[1][1];
    const float rr = (1.f / sqrtf(wsum(dx * dx + dy * dy) * (1.f / 128.f) + 1e-5f)) * 0.8f;
    const float vx = dx * rr * subg[2 * lane], vy = dy * rr * subg[2 * lane + 1];
    unsigned ux = __builtin_bit_cast(unsigned, vx), uy = __builtin_bit_cast(unsigned, vy);
    ux = (ux + 0x7fffu + ((ux >> 16) & 1u)) >> 16; uy = (uy + 0x7fffu + ((uy >> 16) & 1u)) >> 16;
    *(unsigned*)(MIX + (size_t)(MP + rs) * 1024 + 512 + h * 128 + 2 * lane) = ux | (uy << 16);
}
}

namespace sk {
typedef float f32x16 __attribute__((ext_vector_type(16)));
typedef short bf16x8 __attribute__((ext_vector_type(8)));
__device__ __forceinline__ int crow(int r, int hi) { return (r & 3) + 8 * (r >> 2) + 4 * hi; }
__device__ __forceinline__ float half_sum(float v) {
#pragma unroll
    for (int o = 1; o < 32; o <<= 1) v += __shfl_xor(v, o);
    return v;
}
__device__ __forceinline__ unsigned short bf(float f) { unsigned u = __builtin_bit_cast(unsigned, f); return (unsigned short)((u + 0x7fffu + ((u >> 16) & 1u)) >> 16); }
template <int KSPLIT, class Epi>
__device__ __forceinline__ void sk_gemm(const unsigned short* A, const unsigned short* Bt, int N, int K, const Epi& E, char* shm, int vcu, int G) {
    int tid_ = threadIdx.x; asm volatile("" : "+v"(tid_));
    const int lane = tid_ & 63, r32 = lane & 31, hi = lane >> 5; const int wid = __builtin_amdgcn_readfirstlane(tid_ >> 6);
    constexpr int TPW = 8 / KSPLIT;
    const int nslot = (8 * (N / 32)) / TPW, KW = K / KSPLIT, nk = KW / 16;
    float* part = (float*)shm;
    for (int slot = vcu; slot < nslot; slot += G) {
        const int tile = slot * TPW + wid / KSPLIT, ks = wid % KSPLIT, tm = tile & 7, tn = tile >> 3;
        const unsigned short* ap = A + (size_t)(tm * 32 + r32) * K + ks * KW + 8 * hi;
        const unsigned short* bp = Bt + (size_t)(tn * 32 + r32) * K + ks * KW + 8 * hi;
        f32x16 acc = {};
        for (int s = 0; s < nk; s += 8) {
            bf16x8 a[8], b[8];
#pragma unroll
            for (int j = 0; j < 8; ++j) { a[j] = *(const bf16x8*)(ap + (s + j) * 16); b[j] = *(const bf16x8*)(bp + (s + j) * 16); }
#pragma unroll
            for (int j = 0; j < 8; ++j) acc = __builtin_amdgcn_mfma_f32_32x32x16_bf16(a[j], b[j], acc, 0, 0, 0);
        }
        if (ks != 0) {
#pragma unroll
            for (int r = 0; r < 16; ++r) part[(wid * 16 + r) * 64 + lane] = acc[r];
        }
        asm volatile("s_waitcnt lgkmcnt(0)" ::: "memory"); __builtin_amdgcn_s_barrier(); asm volatile("" ::: "memory");
        if (ks == 0) {
#pragma unroll
            for (int j = 1; j < KSPLIT; ++j)
#pragma unroll
                for (int r = 0; r < 16; ++r) acc[r] += part[((wid + j) * 16 + r) * 64 + lane];
            E(acc, tm, tn, r32, hi);
        }
        asm volatile("s_waitcnt lgkmcnt(0)" ::: "memory"); __builtin_amdgcn_s_barrier(); asm volatile("" ::: "memory");
    }
}
struct EpiIn {
    unsigned short* planes; size_t plane_elems; int row0; float* oks; float* ovs; float qscale;
    __device__ __forceinline__ void operator()(const f32x16& acc, int tm, int tn, int r32, int hi) const {
        const int col = tn * 32 + r32, t = col >> 9, pc = col & 511; const float sc = (t == 3) ? qscale : 1.f;
        unsigned short* pb = planes + (size_t)t * plane_elems + (size_t)row0 * 512 + pc;
        float* ob = (t == 4) ? oks : (t == 5) ? ovs : nullptr;
#pragma unroll
        for (int r = 0; r < 16; ++r) { const int rs = tm * 32 + crow(r, hi); pb[(size_t)rs * 512] = bf(acc[r] * sc); if (ob) ob[(size_t)rs * 512 + pc] = acc[r]; }
    }
};
template <bool WRITE_BF> struct EpiRes {
    const float* base; float* out; unsigned short* outb; float* ssq;
    __device__ __forceinline__ void operator()(const f32x16& acc, int tm, int tn, int r32, int hi) const {
        const int col = tn * 32 + r32;
#pragma unroll
        for (int r = 0; r < 16; ++r) { const int rs = tm * 32 + crow(r, hi); const size_t o = (size_t)rs * 1024 + col; const float v = base[o] + acc[r];
            out[o] = v; if (WRITE_BF) outb[o] = bf(v);
            const float s = half_sum(v * v); if (r32 == 0) ssq[rs * 32 + tn] = s; }
    }
};
struct EpiUp {
    unsigned short* O; const float* ssq; float eps;
    __device__ __forceinline__ void operator()(const f32x16& acc, int tm, int tn, int r32, int hi) const {
        const int col = tn * 32 + r32;
#pragma unroll
        for (int r = 0; r < 16; ++r) { const int rs = tm * 32 + crow(r, hi); const float tot = half_sum(ssq[rs * 32 + r32]);
            const float rstd = 1.0f / sqrtf(tot * (1.0f / 1024.0f) + eps); float v = fmaxf(acc[r] * rstd, 0.f); v *= v;
            O[(size_t)rs * 4096 + col] = bf(v); }
    }
};
}


constexpr int NWAVES = 8;
constexpr int D = 1024, SEQ = 2048, BATCH = 8, MP = BATCH * SEQ, DEC_B = 32, DEC_S = 8, MS = DEC_B * DEC_S, MT = MP + MS;
constexpr int DIN = 3072, FF = 4096, PAST = 8192, PAGE = 128, NPAGES = PAST / PAGE;
constexpr float EPS = 1e-5f, LOG2E = 1.4426950408889634f, QSCALE = 0.125f * LOG2E;
constexpr size_t O_Y = 0, O_KP = (size_t)MT * D, O_VP = O_KP + (size_t)MP * 512, O_CP = O_VP + (size_t)MP * 512,
                 O_KS = O_CP + 8 * 2 * 512, O_VS = O_KS + (size_t)MS * 512, O_CS = O_VS + (size_t)MS * 512, O_END = O_CS + 32 * 2 * 512;
static_assert(O_END == 34119680, "out size");
constexpr size_t MiB = 1u << 20;
constexpr size_t WS_CTL = 0, CTL_ZERO_BYTES = 1 * MiB;
constexpr size_t WS_WIN = 2 * MiB, WS_WO = 8 * MiB, WS_W1 = 10 * MiB, WS_W2 = 18 * MiB;
constexpr size_t WS_SSQA = 30 * MiB;
constexpr size_t WS_SSQ1 = 26 * MiB, WS_SSQ2 = 28 * MiB, WS_SSQS1 = 27 * MiB + 512 * 1024, WS_SSQS2 = 29 * MiB + 512 * 1024;
constexpr size_t WS_XN = 32 * MiB;
constexpr size_t PLANE_ELEMS = (size_t)MT * 512, WS_PL = 65 * MiB;
constexpr size_t WS_MIX = 163 * MiB, WS_X1 = 196 * MiB, WS_X1B = 261 * MiB, WS_HB = 294 * MiB, WS_PART = 424 * MiB, WS_END = 434 * MiB;
static_assert(WS_PL + 6 * PLANE_ELEMS * 2 <= WS_MIX && WS_XN + (size_t)MT * D * 2 <= WS_PL && WS_MIX + (size_t)MT * D * 2 <= WS_X1 && WS_X1 + (size_t)MT * D * 4 <= WS_X1B
              && WS_X1B + (size_t)MT * D * 2 <= WS_HB && WS_HB + (size_t)MT * FF * 2 <= WS_PART && WS_PART + (size_t)256 * 4 * dec::PART_FLOATS * 4 <= WS_END && WS_SSQ1 + (size_t)MT * 64 <= WS_SSQ2 && WS_SSQ2 + (size_t)MT * 64 <= WS_XN, "d_ws map");
constexpr int CW_BAR = 4096;
constexpr int RING_OFF = 0, RING_BYTES = 131072, LDSCTL_OFF = RING_BYTES, MISC_OFF = LDSCTL_OFF + 320, LDS_BYTES = 147456;

__device__ __forceinline__ float bflo(unsigned w) { return __builtin_bit_cast(float, w << 16); }
__device__ __forceinline__ float bfhi(unsigned w) { return __builtin_bit_cast(float, w & 0xffff0000u); }
__device__ __forceinline__ float wave_sum(float v) {
#pragma unroll
    for (int o = 1; o < 64; o <<= 1) v += __shfl_xor(v, o);
    return v;
}
__device__ __forceinline__ float wave_max(float v) {
#pragma unroll
    for (int o = 1; o < 64; o <<= 1) v = fmaxf(v, __shfl_xor(v, o));
    return v;
}

__device__ __forceinline__ void p0_transpose_item(const float* W, int K, int N, bf16* WT, const float* gk, LAS float* scr, int item, int lane) {
    const int nblk = N / 32, kb = item / nblk, nb = item % nblk, k0 = 64 * kb, n0 = 32 * nb;
#pragma unroll 8
    for (int i = 0; i < 32; ++i) { const int kk = 2 * i + (lane >> 5); float w = W[(size_t)(k0 + kk) * N + n0 + (lane & 31)]; if (gk) w *= gk[k0 + kk]; scr[kk * 33 + (lane & 31)] = w; }
    LDS_WAIT(); asm volatile("" ::: "memory");
    const int c = lane & 7;
#pragma unroll
    for (int j = 0; j < 4; ++j) { const int n = (lane >> 3) + 8 * j; const LAS float* s = scr + (8 * c) * 33 + n;
        v4u o; o.x = pk2(s[0 * 33], s[1 * 33]); o.y = pk2(s[2 * 33], s[3 * 33]); o.z = pk2(s[4 * 33], s[5 * 33]); o.w = pk2(s[6 * 33], s[7 * 33]);
        *(GAS v4u*)(WT + (size_t)(n0 + n) * K + k0 + 8 * c) = o; }
    LDS_WAIT(); asm volatile("" ::: "memory");
}
__device__ __forceinline__ void rms_row_to_bf16(const float* xrow, const float* g, bf16* orow, int lane) {
    const GAS f32x4* xr = (const GAS f32x4*)xrow + lane; const GAS f32x4* gr = (const GAS f32x4*)g + lane;
    f32x4 v[4]; float s = 0.f;
#pragma unroll
    for (int j = 0; j < 4; ++j) { v[j] = xr[64 * j]; s += (v[j].x * v[j].x + v[j].y * v[j].y) + (v[j].z * v[j].z + v[j].w * v[j].w); }
    const float rstd = 1.f / sqrtf(wave_sum(s) * (1.f / D) + EPS);
    GAS unsigned long long* o8 = (GAS unsigned long long*)orow + lane;
#pragma unroll
    for (int j = 0; j < 4; ++j) { const f32x4 gg = gr[64 * j];
        o8[64 * j] = (unsigned long long)pk2(v[j].x * rstd * gg.x, v[j].y * rstd * gg.y) | ((unsigned long long)pk2(v[j].z * rstd * gg.z, v[j].w * rstd * gg.w) << 32); }
}


#ifndef REP_P0
#define REP_P0 1
#endif
#ifndef REP_P1
#define REP_P1 1
#endif
#ifndef REP_P2
#define REP_P2 1
#endif
#ifndef REP_P2b
#define REP_P2b 1
#endif
#ifndef REP_P3
#define REP_P3 1
#endif
#ifndef REP_P4
#define REP_P4 1
#endif
#ifndef REP_P5
#define REP_P5 1
#endif
#ifndef REP_ATT
#define REP_ATT 1
#endif
#ifndef REP_DEC
#define REP_DEC 1
#endif
#define PH_BEGIN(k) for (int rep_ = 0; rep_ < REP_##k; ++rep_) {
#define PH_END }
struct Args { const void* in[19]; float* out; unsigned char* ws; };

__device__ __forceinline__ void p2_conv(const bf16* PB, const bf16* PC, const bf16* PU, const float* state, const float* cw, bf16* MIX, float* out, int gtid, int nthr) {
    for (int it = gtid; it < MT * 64; it += nthr) {
        const int r = it >> 6, ch = (it & 63) * 8;
        int t, T, seq; const float* st = nullptr; size_t ocs;
        if (r < MP) { t = r % SEQ; T = SEQ; seq = r / SEQ; ocs = O_CP; } else { const int q = r - MP; t = q % DEC_S; T = DEC_S; seq = q / DEC_S; st = state + (size_t)seq * 2 * 512; ocs = O_CS; }
        float e[3][8];
#pragma unroll
        for (int j = 0; j < 3; ++j) { const int ei = t + j;
            if (ei < 2) {
#pragma unroll
                for (int k = 0; k < 8; ++k) e[j][k] = st ? st[ei * 512 + ch + k] : 0.f;
            } else { const size_t o = (size_t)(r - 2 + j) * 512 + ch; const v4u c = *(const GAS v4u*)(PC + o), u = *(const GAS v4u*)(PU + o);
#pragma unroll
                for (int k = 0; k < 4; ++k) { e[j][2 * k] = bflo(c[k]) * bflo(u[k]); e[j][2 * k + 1] = bfhi(c[k]) * bfhi(u[k]); } } }
        const v4u b = *(const GAS v4u*)(PB + (size_t)r * 512 + ch);
        float y[8];
#pragma unroll
        for (int k = 0; k < 8; ++k) y[k] = e[0][k] * cw[ch + k] + e[1][k] * cw[512 + ch + k] + e[2][k] * cw[1024 + ch + k];
        v4u o;
#pragma unroll
        for (int k = 0; k < 4; ++k) o[k] = pk2(bflo(b[k]) * y[2 * k], bfhi(b[k]) * y[2 * k + 1]);
        *(GAS v4u*)(MIX + (size_t)r * D + ch) = o;
        if (t >= T - 2) { float* oc = out + ocs + ((size_t)seq * 2 + (t - (T - 2))) * 512 + ch;
            *(f32x4*)oc = (f32x4){e[2][0], e[2][1], e[2][2], e[2][3]}; *(f32x4*)(oc + 4) = (f32x4){e[2][4], e[2][5], e[2][6], e[2][7]}; }
    }
}
__device__ __forceinline__ void p2_attn_naive(const bf16* PQ, const bf16* PK, const bf16* PV, const float* ck, const float* cv, const int* pt, float lam, const float* subg,
                                              bf16* MIX, LAS float* qs, int gw, int ngw, int lane, int row_lo, int row_hi) {
    for (int task = gw; task < (row_hi - row_lo) * 4; task += ngw) {
        const int r = row_lo + (task >> 2), h = task & 3;
        const float slope2 = exp2f(-2.f * (h + 1)) * LOG2E;
        const bool dec = r >= MP;
        int qpos, bd = 0, rowbase;
        if (!dec) { qpos = r % SEQ; rowbase = r - qpos; } else { const int q = r - MP; bd = q / DEC_S; qpos = PAST + q % DEC_S; rowbase = MP + bd * DEC_S - PAST; }
        { const unsigned w = *(const GAS unsigned*)(PQ + (size_t)r * 512 + h * 128 + 2 * lane); qs[2 * lane] = bflo(w); qs[2 * lane + 1] = bfhi(w); }
        LDS_WAIT(); asm volatile("" ::: "memory");
        float m1 = -1e30f, m2 = -1e30f, l1 = 0.f, l2 = 0.f, a1x = 0.f, a1y = 0.f, a2x = 0.f, a2y = 0.f;
        for (int j0 = 0; j0 <= qpos; j0 += 64) {
            const int j = j0 + lane; const bool valid = j <= qpos;
            float s1 = -1e30f, s2 = -1e30f;
            if (valid) {
                float d1 = 0.f, d2 = 0.f;
                if (dec && j < PAST) { const int pg = pt[bd * NPAGES + j / PAGE]; const float* kp = ck + (((size_t)pg * PAGE + (j % PAGE)) * 4 + h) * 128;
#pragma unroll 4
                    for (int d = 0; d < 64; d += 4) { const f32x4 ka = *(const GAS f32x4*)(kp + d), kb = *(const GAS f32x4*)(kp + 64 + d);
                        d1 += qs[d] * ka.x + qs[d + 1] * ka.y + qs[d + 2] * ka.z + qs[d + 3] * ka.w;
                        d2 += qs[64 + d] * kb.x + qs[64 + d + 1] * kb.y + qs[64 + d + 2] * kb.z + qs[64 + d + 3] * kb.w; }
                } else { const bf16* kp = PK + (size_t)(rowbase + j) * 512 + h * 128;
#pragma unroll 2
                    for (int d = 0; d < 64; d += 8) { const v4u ka = *(const GAS v4u*)(kp + d), kb = *(const GAS v4u*)(kp + 64 + d);
#pragma unroll
                        for (int k = 0; k < 4; ++k) { d1 += qs[d + 2 * k] * bflo(ka[k]) + qs[d + 2 * k + 1] * bfhi(ka[k]); d2 += qs[64 + d + 2 * k] * bflo(kb[k]) + qs[64 + d + 2 * k + 1] * bfhi(kb[k]); } }
                }
                const float bias = -slope2 * (float)(qpos - j);
                s1 = d1 + bias; s2 = d2 + bias;
            }
            const float n1 = fmaxf(m1, wave_max(s1)), n2 = fmaxf(m2, wave_max(s2));
            const float f1 = exp2f(m1 - n1), f2 = exp2f(m2 - n2);
            const float p1 = valid ? exp2f(s1 - n1) : 0.f, p2 = valid ? exp2f(s2 - n2) : 0.f;
            l1 = l1 * f1 + wave_sum(p1); l2 = l2 * f2 + wave_sum(p2);
            a1x *= f1; a1y *= f1; a2x *= f2; a2y *= f2; m1 = n1; m2 = n2;
            const int jn = min(64, qpos - j0 + 1);
            for (int jj = 0; jj < jn; ++jj) {
                const int jk = j0 + jj; float vx, vy;
                if (dec && jk < PAST) { const int pg = pt[bd * NPAGES + jk / PAGE]; const float* vp = cv + (((size_t)pg * PAGE + (jk % PAGE)) * 4 + h) * 128; vx = vp[2 * lane]; vy = vp[2 * lane + 1]; }
                else { const unsigned w = *(const GAS unsigned*)(PV + (size_t)(rowbase + jk) * 512 + h * 128 + 2 * lane); vx = bflo(w); vy = bfhi(w); }
                const float q1 = __shfl(p1, jj), q2 = __shfl(p2, jj);
                a1x += q1 * vx; a1y += q1 * vy; a2x += q2 * vx; a2y += q2 * vy;
            }
        }
        const float ox = a1x / l1 - lam * (a2x / l2), oy = a1y / l1 - lam * (a2y / l2);
        const float rr = (1.f / sqrtf(wave_sum(ox * ox + oy * oy) * (1.f / 128.f) + EPS)) * 0.8f;
        *(GAS unsigned*)(MIX + (size_t)r * D + 512 + h * 128 + 2 * lane) = pk2(ox * rr * subg[2 * lane], oy * rr * subg[2 * lane + 1]);
        LDS_WAIT(); asm volatile("" ::: "memory");
    }
}

__global__ void __launch_bounds__(NWAVES * 64, 2) hymba_fwd(Args args) {
    extern __shared__ __attribute__((aligned(16))) unsigned char lds_raw[];
    LAS unsigned char* lds = (LAS unsigned char*)lds_raw;
    const int tid = threadIdx.x, lane = tid & 63, wave = __builtin_amdgcn_readfirstlane(tid >> 6);
    const int G = gridDim.x, bx = blockIdx.x;
    const int vcu = (G % 8 == 0) ? (bx % 8) * (G / 8) + bx / 8 : bx;
    unsigned char* ws = args.ws; float* out = args.out;
    const float* x_p = (const float*)args.in[0]; const float* x_s = (const float*)args.in[1];
    const float* ck = (const float*)args.in[2]; const float* cv = (const float*)args.in[3]; const float* state = (const float*)args.in[4];
    const int* pt = (const int*)args.in[5];
    const float* g1 = (const float*)args.in[6]; const float* w_in = (const float*)args.in[7]; const float* cw = (const float*)args.in[8];
    const float* lq1 = (const float*)args.in[9]; const float* lk1 = (const float*)args.in[10]; const float* lq2 = (const float*)args.in[11]; const float* lk2 = (const float*)args.in[12];
    const float* subg = (const float*)args.in[13]; const float* w_out = (const float*)args.in[14]; const float* g2 = (const float*)args.in[15];
    const float* w_up = (const float*)args.in[16]; const float* w_down = (const float*)args.in[17]; const float* gf = (const float*)args.in[18];
    bf16* Win_t = (bf16*)(ws + WS_WIN); bf16* Wo_t = (bf16*)(ws + WS_WO); bf16* W1_t = (bf16*)(ws + WS_W1); bf16* W2_t = (bf16*)(ws + WS_W2);
    float* SSQ1 = (float*)(ws + WS_SSQ1); float* SSQ2 = (float*)(ws + WS_SSQ2); float* SSQS1 = (float*)(ws + WS_SSQS1); float* SSQS2 = (float*)(ws + WS_SSQS2);
    char* shm = (char*)lds_raw + RING_OFF;
    bf16* XN = (bf16*)(ws + WS_XN); bf16* PL = (bf16*)(ws + WS_PL); bf16* MIX = (bf16*)(ws + WS_MIX);
    float* X1 = (float*)(ws + WS_X1); bf16* X1B = (bf16*)(ws + WS_X1B); bf16* HB = (bf16*)(ws + WS_HB);
    unsigned* ctl = (unsigned*)(ws + WS_CTL);

    for (int u = tid; u < (LDS_BYTES - LDSCTL_OFF) / 4; u += NWAVES * 64) ((LAS unsigned*)(lds + LDSCTL_OFF))[u] = 0u;
    __syncthreads();
    XcdBarrier bar = xcd_barrier_post(ctl + CW_BAR, (volatile LAS unsigned*)(lds + MISC_OFF) + 8);
    const int gw = vcu * NWAVES + wave, NGW = G * NWAVES;

    PH_BEGIN(P0)
    {
        LAS float* scr = (LAS float*)(lds + RING_OFF + wave * 16384);
        constexpr int I_IN = (D / 64) * (DIN / 32), I_O = (D / 64) * (D / 32), I_1 = (D / 64) * (FF / 32), I_2 = (FF / 64) * (D / 32);
        constexpr int NITEMS = I_IN + I_O + I_1 + I_2;
        for (int it = gw; it < NITEMS; it += NGW) {
            int r = it;
            if (r < I_IN) { p0_transpose_item(w_in, D, DIN, Win_t, nullptr, scr, r, lane); continue; } r -= I_IN;
            if (r < I_O) { p0_transpose_item(w_out, D, D, Wo_t, nullptr, scr, r, lane); continue; } r -= I_O;
            if (r < I_1) { p0_transpose_item(w_up, D, FF, W1_t, g2, scr, r, lane); continue; } r -= I_1;
            p0_transpose_item(w_down, FF, D, W2_t, nullptr, scr, r, lane);
        }
        for (int m = gw; m < MT; m += NGW) rms_row_to_bf16(m < MP ? x_p + (size_t)m * D : x_s + (size_t)(m - MP) * D, g1, XN + (size_t)m * D, lane);
    }
    xcd_barrier(bar);
    PH_END

    PH_BEGIN(P1)
    {
        { sk::EpiIn Es{PL, PLANE_ELEMS, MP, out + O_KS, out + O_VS, QSCALE}; sk::sk_gemm<2>(XN + (size_t)MP * D, Win_t, DIN, D, Es, shm, vcu, G); }
        pg8::Gemm g{XN, Win_t, MP, DIN, D}; pg8::StaticOrder S; S.init(MP, DIN, G, bx);
        pg8::EpiInProj E{PL, PLANE_ELEMS, out + O_KP, out + O_VP, out + O_KS, out + O_VS, QSCALE};
        pg8::gemm_phase<pg8::EpiInProj, pg8::StaticOrder, true, true>(lds + RING_OFF, g, S, E);
    }
    xcd_barrier(bar);
    PH_END

    const float lam_v = exp2f(wave_sum(lq1[lane] * lk1[lane]) * LOG2E) - exp2f(wave_sum(lq2[lane] * lk2[lane]) * LOG2E) + 0.2f;
    const float lam = __builtin_bit_cast(float, __builtin_amdgcn_readfirstlane(__builtin_bit_cast(int, lam_v)));
    PH_BEGIN(P2)
    {
        p2_conv(PL, PL + PLANE_ELEMS, PL + 2 * PLANE_ELEMS, state, cw, MIX, out, bx * NWAVES * 64 + tid, G * NWAVES * 64);
        const bf16* PQ = PL + 3 * PLANE_ELEMS; const bf16* PK = PL + 4 * PLANE_ELEMS; const bf16* PV = PL + 5 * PLANE_ELEMS;
        float* PART = (float*)(ws + WS_PART); float* SSQA = (float*)(ws + WS_SSQA);
#ifdef ALL_DEC_FIRST
        const bool attn_first = false;
#else
        const bool attn_first = (vcu & 1) == 0;
#endif
        for (int slot = 0; slot < 2; ++slot) {
            if ((slot == 0) == attn_first) {
                for (int ra_ = 0; ra_ < REP_ATT; ++ra_)
                for (int u = vcu; u < 256; u += G) {
                    const int b = u >> 5, h = (u >> 3) & 3, j = u & 7;
                    for (int s4 = 0; s4 < 4; ++s4)
                        dattn::attn_sub<8>(b, h, (s4 < 2) ? j : 7 - j, s4 >> 1, s4 & 1, (const dattn::bf16*)PQ, (const dattn::bf16*)PK, (const dattn::bf16*)PV, MIX, SSQA, lam, (char*)lds_raw + RING_OFF);
                }
            } else {
                for (int rd_ = 0; rd_ < REP_DEC; ++rd_)
                for (int u = vcu; u < 256; u += G)
                    dec::dec_item(u >> 3, (u & 7) * 8, 8, PQ, ck, cv, pt, PART + (size_t)u * 4 * dec::PART_FLOATS, (char*)lds_raw + RING_OFF);
            }
        }
    }
    xcd_barrier(bar);
    PH_END

    PH_BEGIN(P2b)
    {
        const float* PART = (const float*)(ws + WS_PART); const float* SSQA = (const float*)(ws + WS_SSQA);
        for (int m = gw; m < MP; m += NGW) {
            const int hh = lane >> 4; const float2 sq = *(const float2*)(SSQA + (size_t)m * 8 + hh * 2);
            const float rr = (1.f / sqrtf((sq.x + sq.y) * (1.f / 128.f) + EPS)) * 0.8f;
            GAS v4u* p = (GAS v4u*)(MIX + (size_t)m * D + 512) + lane; const v4u w = *p; const GAS f32x4* gp = (const GAS f32x4*)(subg + (lane & 15) * 8); const f32x4 g0 = gp[0], g1 = gp[1];
            v4u o; o.x = pk2(bflo(w.x) * rr * g0.x, bfhi(w.x) * rr * g0.y); o.y = pk2(bflo(w.y) * rr * g0.z, bfhi(w.y) * rr * g0.w);
            o.z = pk2(bflo(w.z) * rr * g1.x, bfhi(w.z) * rr * g1.y); o.w = pk2(bflo(w.w) * rr * g1.z, bfhi(w.w) * rr * g1.w); *p = o;
        }
        for (int task = gw; task < MS * 4; task += NGW) { const int rs = task >> 2;
            dec::dec_combine(rs, task & 3, 8, PART + (size_t)(rs >> 3) * 8 * 4 * dec::PART_FLOATS, PL + 3 * PLANE_ELEMS, PL + 4 * PLANE_ELEMS, PL + 5 * PLANE_ELEMS, lam, subg, MIX, lane); }
    }
    xcd_barrier(bar);
    PH_END

    PH_BEGIN(P3)
    {
        { sk::EpiRes<true> Es{x_s, X1 + (size_t)MP * D, X1B + (size_t)MP * D, SSQS1}; sk::sk_gemm<8>(MIX + (size_t)MP * D, Wo_t, D, D, Es, shm, vcu, G); }
        pg8::Gemm g{MIX, Wo_t, MP, D, D}; pg8::StaticOrder S; S.init(MP, D, G, bx);
        pg8::EpiResid<true> E{x_p, x_s, X1, X1B, SSQ1};
        pg8::gemm_phase<pg8::EpiResid<true>, pg8::StaticOrder, true, true>(lds + RING_OFF, g, S, E);
    }
    xcd_barrier(bar);
    PH_END

    PH_BEGIN(P4)
    {
        { sk::EpiUp Es{HB + (size_t)MP * FF, SSQS1, EPS}; sk::sk_gemm<2>(X1B + (size_t)MP * D, W1_t, FF, D, Es, shm, vcu, G); }
        pg8::Gemm g{X1B, W1_t, MP, FF, D}; pg8::StaticOrder S; S.init(MP, FF, G, bx);
        pg8::EpiUp E{HB, FF, SSQ1, EPS};
        pg8::gemm_phase<pg8::EpiUp, pg8::StaticOrder, true, true>(lds + RING_OFF, g, S, E);
    }
    xcd_barrier(bar);
    PH_END

    PH_BEGIN(P5)
    {
        { sk::EpiRes<false> Es{X1 + (size_t)MP * D, out + O_Y + (size_t)MP * D, nullptr, SSQS2}; sk::sk_gemm<8>(HB + (size_t)MP * FF, W2_t, D, FF, Es, shm, vcu, G); }
        pg8::Gemm g{HB, W2_t, MP, D, FF}; pg8::StaticOrder S; S.init(MP, D, G, bx);
        pg8::EpiResid<false> E{X1, X1 + (size_t)MP * D, out + O_Y, nullptr, SSQ2};
        pg8::gemm_phase<pg8::EpiResid<false>, pg8::StaticOrder, true, true>(lds + RING_OFF, g, S, E);
    }
    xcd_barrier(bar);
    PH_END

    for (int m = gw; m < MT; m += NGW) {
        GAS f32x4* yr = (GAS f32x4*)(out + O_Y + (size_t)m * D) + lane; const GAS f32x4* gr = (const GAS f32x4*)gf + lane;
        const float sp = (m < MP) ? ((lane < 16) ? SSQ2[(size_t)m * 16 + lane] : 0.f) : ((lane < 32) ? SSQS2[(size_t)(m - MP) * 32 + lane] : 0.f);
        float tot = sp; tot += __shfl_xor(tot, 1); tot += __shfl_xor(tot, 2); tot += __shfl_xor(tot, 4); tot += __shfl_xor(tot, 8); tot += __shfl_xor(tot, 16);
        tot = __shfl(tot, 0);
        const float rstd = 1.f / sqrtf(tot * (1.f / D) + EPS);
#pragma unroll
        for (int j = 0; j < 4; ++j) { const f32x4 v = yr[64 * j], gg = gr[64 * j]; yr[64 * j] = (f32x4){v.x * rstd * gg.x, v.y * rstd * gg.y, v.z * rstd * gg.z, v.w * rstd * gg.w}; }
    }
}

extern "C" void kernel_launch(void* const* d_in, const int* in_sizes, int n_in, void* d_out, int out_size, void* d_ws, size_t ws_size, hipStream_t stream) {
    static int grid = 0;
    if (grid == 0) {
        if (n_in != 19 || out_size != (int)O_END || ws_size < WS_END) { fprintf(stderr, "kernel_launch: unexpected shapes (n_in %d out %d ws %zu)\n", n_in, out_size, ws_size); grid = -1; return; }
        int dev = 0, cus = 0, per_cu = 0;
        if (hipGetDevice(&dev) != hipSuccess || hipDeviceGetAttribute(&cus, hipDeviceAttributeMultiprocessorCount, dev) != hipSuccess) { grid = -1; return; }
        if (hipFuncSetAttribute((const void*)hymba_fwd, hipFuncAttributeMaxDynamicSharedMemorySize, LDS_BYTES) != hipSuccess) { fprintf(stderr, "kernel_launch: hipFuncSetAttribute failed\n"); grid = -1; return; }
        if (hipOccupancyMaxActiveBlocksPerMultiprocessor(&per_cu, (const void*)hymba_fwd, NWAVES * 64, LDS_BYTES) != hipSuccess || per_cu < 1) { fprintf(stderr, "kernel_launch: occupancy query reports %d\n", per_cu); }
        (void)hipGetLastError();
        grid = cus;
    }
    if (grid < 0) return;
    if (hipMemsetAsync((char*)d_ws + WS_CTL, 0, CTL_ZERO_BYTES, stream) != hipSuccess) return;
    Args a{};
    for (int i = 0; i < 19; ++i) a.in[i] = d_in[i];
    a.out = (float*)d_out; a.ws = (unsigned char*)d_ws;
    hipLaunchKernelGGL(hymba_fwd, dim3(grid), dim3(NWAVES * 64), LDS_BYTES, stream, a);
}
```
